# Optimizing an MI355X kernel written in HIP

```python
import math
import jax, jax.numpy as jnp
from jax import lax
import numpy as np

D_MODEL = 1024
BATCH = 8
SEQ = 4096
DEPTH = 1

ATT_HEADS = 8
ATT_HEAD_DIM = 64
ATT_WIDTH = ATT_HEADS * ATT_HEAD_DIM
IDX_HEADS = 8
IDX_HEAD_DIM = 64
TOPK_MAX = 256
Q_BLOCK = 128
MLSTM_HEADS = 4
MLSTM_QK_DIM = 64
MLSTM_V_DIM = 128
MLSTM_WIDTH = MLSTM_HEADS * MLSTM_V_DIM
MLSTM_CHUNK = 64
CONV_WIDTH = 4
N_BUCKETS = 32
MAX_DISTANCE = 128
N_EXPERTS = 32
TOP_K = 4
D_FF = 1024
SWIGLU_ALPHA = 1.702
SWIGLU_LIMIT = 7.0
MOE_BLOCK = 256
LN_EPS = 1e-5
DEEPNORM_ALPHA = (2 * DEPTH) ** 0.25
DEEPNORM_BETA = (8 * DEPTH) ** -0.25

SPLIT_SIZES = (
    ATT_WIDTH, ATT_WIDTH, ATT_WIDTH,
    IDX_HEADS * IDX_HEAD_DIM, IDX_HEAD_DIM, IDX_HEADS,
    MLSTM_HEADS * MLSTM_QK_DIM, MLSTM_HEADS * MLSTM_QK_DIM, MLSTM_WIDTH,
    MLSTM_HEADS, MLSTM_HEADS, MLSTM_WIDTH,
    D_MODEL, D_MODEL,
)
IN_WIDTH = sum(SPLIT_SIZES)

kernel_name = "hybrid_dsa_mlstm_moe_deepnorm"


def layer_norm(x, g, b):
    xf = x.astype(jnp.float32)
    mu = jnp.mean(xf, axis=-1, keepdims=True)
    var = jnp.mean(jnp.square(xf - mu), axis=-1, keepdims=True)
    y = (xf - mu) * lax.rsqrt(var + LN_EPS)
    return (y * g.astype(jnp.float32) + b.astype(jnp.float32)).astype(x.dtype)


def t5_bucket(rel):
    n = jnp.maximum(rel, 0)
    max_exact = N_BUCKETS // 2
    n_f = jnp.maximum(n, 1).astype(jnp.float32)
    large = max_exact + (jnp.log(n_f / max_exact) / math.log(MAX_DISTANCE / max_exact)
                         * (N_BUCKETS - max_exact)).astype(jnp.int32)
    large = jnp.minimum(large, N_BUCKETS - 1)
    return jnp.where(n < max_exact, n, large)


def dsa_attention(q, k, v, q_idx, k_idx, w_idx, rel_bias):
    B, S, H, Dh = q.shape
    n_sel = min(TOPK_MAX, S // 4)
    n_blk = S // Q_BLOCK
    key_pos = jnp.arange(S, dtype=jnp.int32)

    def to_blocks(a):
        return jnp.moveaxis(a.reshape(B, n_blk, Q_BLOCK, *a.shape[2:]), 1, 0)

    def block(args):
        q_b, qi_b, wi_b, start = args
        t_pos = start + jnp.arange(Q_BLOCK, dtype=jnp.int32)
        dots = jnp.einsum('bqhd,bsd->bqhs', qi_b, k_idx).astype(jnp.float32) * IDX_HEAD_DIM ** -0.5
        score = jnp.einsum('bqh,bqhs->bqs', wi_b.astype(jnp.float32) * IDX_HEADS ** -0.5,
                           jax.nn.relu(dots))
        score = jnp.where(key_pos[None, None, :] <= t_pos[None, :, None], score, -jnp.inf)
        _, sel = lax.top_k(score, n_sel)
        k_g = jax.vmap(lambda kk, ii: kk[ii])(k, sel)
        v_g = jax.vmap(lambda vv, ii: vv[ii])(v, sel)
        rel = t_pos[None, :, None] - sel
        logits = jnp.einsum('bqhd,bqjhd->bqhj', q_b, k_g).astype(jnp.float32) * ATT_HEAD_DIM ** -0.5
        bias = jnp.moveaxis(rel_bias[:, t5_bucket(rel)], 0, 2).astype(jnp.float32)
        logits = jnp.where((rel >= 0)[:, :, None, :], logits + bias, -jnp.inf)
        p = jax.nn.softmax(logits, axis=-1).astype(v.dtype)
        return jnp.einsum('bqhj,bqjhd->bqhd', p, v_g)

    starts = jnp.arange(n_blk, dtype=jnp.int32) * Q_BLOCK
    out = lax.map(block, (to_blocks(q), to_blocks(q_idx), to_blocks(w_idx), starts))
    return jnp.moveaxis(out, 0, 1).reshape(B, S, H * Dh)


def causal_depthwise_conv(x, w, b):
    C = x.shape[-1]
    y = lax.conv_general_dilated(x, w[:, None, :].astype(x.dtype), window_strides=(1,),
                                 padding=[(CONV_WIDTH - 1, 0)],
                                 dimension_numbers=('NWC', 'WIO', 'NWC'),
                                 feature_group_count=C)
    return y + b


def mlstm_chunkwise(q, k, v, i_pre, f_pre):
    B, S, H, Dk = q.shape
    Dv = v.shape[-1]
    L = MLSTM_CHUNK
    NC = S // L
    q = q.reshape(B, NC, L, H, Dk)
    k = k.reshape(B, NC, L, H, Dk)
    v = v.reshape(B, NC, L, H, Dv)
    log_f = jax.nn.log_sigmoid(f_pre).reshape(B, NC, L, H)
    log_i = i_pre.reshape(B, NC, L, H)
    b = jnp.cumsum(log_f, axis=2)
    b_end = b[:, :, -1, :]
    a = b_end[:, :, None, :] - b + log_i
    m_loc = jnp.max(a, axis=2)
    w_loc = jnp.exp(a - m_loc[:, :, None, :])
    c_loc = jnp.einsum('bclh,bclhk,bclhv->bchkv', w_loc, k, v)
    n_loc = jnp.einsum('bclh,bclhk->bchk', w_loc, k)

    def step(carry, inp):
        c, n, m = carry
        cl, nl, ml, be = inp
        m_new = jnp.maximum(be + m, ml)
        decay = jnp.exp(be + m - m_new)
        inject = jnp.exp(ml - m_new)
        c_new = decay[..., None, None] * c + inject[..., None, None] * cl
        n_new = decay[..., None] * n + inject[..., None] * nl
        return (c_new, n_new, m_new), (c, n, m)

    init = (jnp.zeros((B, H, Dk, Dv), jnp.float32), jnp.zeros((B, H, Dk), jnp.float32),
            jnp.zeros((B, H), jnp.float32))
    xs = (jnp.moveaxis(c_loc, 1, 0), jnp.moveaxis(n_loc, 1, 0),
          jnp.moveaxis(m_loc, 1, 0), jnp.moveaxis(b_end, 1, 0))
    _, (c0, n0, m0) = lax.scan(step, init, xs)
    c0 = jnp.moveaxis(c0, 0, 1)
    n0 = jnp.moveaxis(n0, 0, 1)
    m0 = jnp.moveaxis(m0, 0, 1)

    d = b[:, :, :, None, :] - b[:, :, None, :, :] + log_i[:, :, None, :, :]
    causal = jnp.tril(jnp.ones((L, L), dtype=bool))
    d = jnp.where(causal[None, None, :, :, None], d, -jnp.inf)
    m_inter = b + m0[:, :, None, :]
    m_t = jnp.maximum(m_inter, jnp.max(d, axis=3))
    p = jnp.einsum('bcthk,bcshk->bctsh', q, k) * jnp.exp(d - m_t[:, :, :, None, :])
    scale_inter = jnp.exp(m_inter - m_t)
    num = (jnp.einsum('bctsh,bcshv->bcthv', p, v)
           + scale_inter[..., None] * jnp.einsum('bcthk,bchkv->bcthv', q, c0))
    den = jnp.sum(p, axis=3) + scale_inter * jnp.einsum('bcthk,bchk->bcth', q, n0)
    h = num / jnp.maximum(jnp.abs(den), jnp.exp(-m_t))[..., None]
    return h.reshape(B, S, H, Dv)


def token_mixers(x, w_in, conv_w, conv_b, i_bias, f_bias, norm_g,
                 w_branch_attn, w_branch_mlstm, w_out, rel_bias):
    B, S, _ = x.shape
    proj = x @ w_in
    split_points = np.cumsum(SPLIT_SIZES)[:-1].tolist()
    (q_a, k_a, v_a, q_i, k_i, w_i, q_m, k_m, v_m, i_m, f_m, o_m, g_a, g_m) = jnp.split(
        proj, split_points, axis=-1)

    y_att = dsa_attention(q_a.reshape(B, S, ATT_HEADS, ATT_HEAD_DIM),
                          k_a.reshape(B, S, ATT_HEADS, ATT_HEAD_DIM),
                          v_a.reshape(B, S, ATT_HEADS, ATT_HEAD_DIM),
                          q_i.reshape(B, S, IDX_HEADS, IDX_HEAD_DIM), k_i, w_i, rel_bias)

    qk_m = jax.nn.silu(causal_depthwise_conv(jnp.concatenate([q_m, k_m], axis=-1), conv_w, conv_b))
    q_m, k_m = jnp.split(qk_m, 2, axis=-1)
    h_m = mlstm_chunkwise(
        q_m.reshape(B, S, MLSTM_HEADS, MLSTM_QK_DIM).astype(jnp.float32),
        k_m.reshape(B, S, MLSTM_HEADS, MLSTM_QK_DIM).astype(jnp.float32) * MLSTM_QK_DIM ** -0.5,
        v_m.reshape(B, S, MLSTM_HEADS, MLSTM_V_DIM).astype(jnp.float32),
        (i_m + i_bias).astype(jnp.float32),
        (f_m + f_bias).astype(jnp.float32))
    mu = jnp.mean(h_m, axis=-1, keepdims=True)
    var = jnp.mean(jnp.square(h_m - mu), axis=-1, keepdims=True)
    h_m = (h_m - mu) * lax.rsqrt(var + LN_EPS) * norm_g.reshape(MLSTM_HEADS, MLSTM_V_DIM).astype(jnp.float32)
    h_m = h_m * jax.nn.sigmoid(o_m.reshape(B, S, MLSTM_HEADS, MLSTM_V_DIM).astype(jnp.float32))
    y_m = h_m.reshape(B, S, MLSTM_WIDTH).astype(x.dtype)

    mix = jax.nn.sigmoid(g_a) * (y_att @ w_branch_attn) + jax.nn.sigmoid(g_m) * (y_m @ w_branch_mlstm)
    return mix @ w_out


def moe_ffn(h, w_router, b_router, w_gate_up, b_gate_up, w_down, b_down):
    B, S, D = h.shape
    T = B * S
    xt = h.reshape(T, D)
    logits = (xt @ w_router + b_router).astype(jnp.float32)
    top_vals, top_idx = lax.top_k(logits, TOP_K)
    gates = jax.nn.softmax(top_vals, axis=-1)
    P = T * TOP_K
    e_flat = top_idx.reshape(P)
    tok_flat = jnp.arange(P, dtype=jnp.int32) // TOP_K
    g_flat = gates.reshape(P)
    order = jnp.argsort(e_flat)
    e_sorted = e_flat[order]
    counts = jnp.bincount(e_flat, length=N_EXPERTS)
    start = jnp.cumsum(counts) - counts
    padded = ((counts + MOE_BLOCK - 1) // MOE_BLOCK) * MOE_BLOCK
    pend = jnp.cumsum(padded)
    pstart = pend - padded
    dest = pstart[e_sorted] + (jnp.arange(P, dtype=jnp.int32) - start[e_sorted])
    cap = ((P + MOE_BLOCK - 1) // MOE_BLOCK) * MOE_BLOCK + N_EXPERTS * MOE_BLOCK
    n_blocks = cap // MOE_BLOCK
    buf_tok = jnp.zeros((cap,), jnp.int32).at[dest].set(tok_flat[order])
    buf_gate = jnp.zeros((cap,), jnp.float32).at[dest].set(g_flat[order])
    block_expert = jnp.searchsorted(pend, jnp.arange(n_blocks, dtype=jnp.int32) * MOE_BLOCK, side='right')
    block_expert = jnp.minimum(block_expert, N_EXPERTS - 1)

    def expert_block(args):
        tok, e = args
        xb = xt[tok]
        gu = xb @ w_gate_up[e] + b_gate_up[e]
        gate, up = gu[:, :D_FF], gu[:, D_FF:]
        gate = jnp.minimum(gate, SWIGLU_LIMIT)
        up = jnp.clip(up, -SWIGLU_LIMIT, SWIGLU_LIMIT)
        act = (up + 1) * (gate * jax.nn.sigmoid(SWIGLU_ALPHA * gate))
        return act @ w_down[e] + b_down[e]

    y_blocks = lax.map(expert_block, (buf_tok.reshape(n_blocks, MOE_BLOCK), block_expert))
    y_buf = y_blocks.reshape(cap, D) * buf_gate[:, None].astype(h.dtype)
    y = jnp.zeros((T, D), h.dtype).at[buf_tok].add(y_buf)
    return y.reshape(B, S, D)


def setup_inputs(seed: int = 0) -> dict:
    key = jax.random.key(seed)
    ks = jax.random.split(key, 21)
    nrm = jax.random.normal
    qk_cols = 2 * MLSTM_HEADS * MLSTM_QK_DIM
    return {
        "x": nrm(ks[0], (BATCH, SEQ, D_MODEL), jnp.float32),
        "w_in": nrm(ks[1], (DEPTH, D_MODEL, IN_WIDTH), jnp.float32) * D_MODEL ** -0.5,
        "conv_w": nrm(ks[2], (DEPTH, CONV_WIDTH, qk_cols), jnp.float32) * CONV_WIDTH ** -0.5,
        "conv_b": 0.02 * nrm(ks[3], (DEPTH, qk_cols), jnp.float32),
        "mlstm_i_bias": -2.0 + 0.1 * nrm(ks[4], (DEPTH, MLSTM_HEADS), jnp.float32),
        "mlstm_f_bias": jnp.linspace(3.0, 6.0, MLSTM_HEADS, dtype=jnp.float32)
                        + 0.1 * nrm(ks[5], (DEPTH, MLSTM_HEADS), jnp.float32),
        "mlstm_norm_g": 1.0 + 0.02 * nrm(ks[6], (DEPTH, MLSTM_WIDTH), jnp.float32),
        "w_branch_attn": nrm(ks[7], (DEPTH, ATT_WIDTH, D_MODEL), jnp.float32) * ATT_WIDTH ** -0.5,
        "w_branch_mlstm": nrm(ks[8], (DEPTH, MLSTM_WIDTH, D_MODEL), jnp.float32) * MLSTM_WIDTH ** -0.5,
        "w_out": nrm(ks[9], (DEPTH, D_MODEL, D_MODEL), jnp.float32) * (D_MODEL ** -0.5 * DEEPNORM_BETA),
        "ln1_g": 1.0 + 0.02 * nrm(ks[10], (DEPTH, D_MODEL), jnp.float32),
        "ln1_b": 0.02 * nrm(ks[11], (DEPTH, D_MODEL), jnp.float32),
        "w_router": nrm(ks[12], (DEPTH, D_MODEL, N_EXPERTS), jnp.float32) * D_MODEL ** -0.5,
        "b_router": 0.01 * nrm(ks[13], (DEPTH, N_EXPERTS), jnp.float32),
        "w_gate_up": nrm(ks[14], (DEPTH, N_EXPERTS, D_MODEL, 2 * D_FF), jnp.float32) * D_MODEL ** -0.5,
        "b_gate_up": 0.02 * nrm(ks[15], (DEPTH, N_EXPERTS, 2 * D_FF), jnp.float32),
        "w_down": nrm(ks[16], (DEPTH, N_EXPERTS, D_FF, D_MODEL), jnp.float32) * (D_FF ** -0.5 * DEEPNORM_BETA),
        "b_down": 0.02 * nrm(ks[17], (DEPTH, N_EXPERTS, D_MODEL), jnp.float32),
        "ln2_g": 1.0 + 0.02 * nrm(ks[18], (DEPTH, D_MODEL), jnp.float32),
        "ln2_b": 0.02 * nrm(ks[19], (DEPTH, D_MODEL), jnp.float32),
        "rel_bias": 0.5 * nrm(ks[20], (ATT_HEADS, N_BUCKETS), jnp.float32),
    }


def reference(x, w_in, conv_w, conv_b, mlstm_i_bias, mlstm_f_bias, mlstm_norm_g,
              w_branch_attn, w_branch_mlstm, w_out, ln1_g, ln1_b, w_router, b_router,
              w_gate_up, b_gate_up, w_down, b_down, ln2_g, ln2_b, rel_bias):
    for l in range(DEPTH):
        y = token_mixers(x, w_in[l], conv_w[l], conv_b[l], mlstm_i_bias[l], mlstm_f_bias[l],
                         mlstm_norm_g[l], w_branch_attn[l], w_branch_mlstm[l], w_out[l], rel_bias)
        x = layer_norm(DEEPNORM_ALPHA * x + y, ln1_g[l], ln1_b[l])
        y = moe_ffn(x, w_router[l], b_router[l], w_gate_up[l], b_gate_up[l], w_down[l], b_down[l])
        x = layer_norm(DEEPNORM_ALPHA * x + y, ln2_g[l], ln2_b[l])
    return x
```

```cpp
#include <hip/hip_runtime.h>
#include <cstdio>
#include <cstdint>

#ifndef MK_PER_PHASE
#define MK_PER_PHASE 1
#endif

constexpr int BATCH = 8, SEQ = 4096, T = BATCH * SEQ, DM = 1024;
constexpr int NPJ = 5632;
constexpr int C_QA = 0, C_KA = 512, C_VA = 1024, C_QI = 1536, C_QM = 2048, C_KM = 2304, C_VM = 2560, C_OM = 3072, C_GA = 3584, C_GM = 4608;
constexpr int NWIN = 5888;
constexpr int NE = 32, DFF = 1024, ECAP = 32768;
constexpr float LN_EPS = 1e-5f;
constexpr float DN_ALPHA = 1.189207115002721f;
constexpr int NPHASE = 12;

constexpr size_t MiB = 1u << 20;
constexpr size_t WS_CTL = 0, CTL_BYTES = 1 * MiB;
constexpr size_t WS_WIN = 1 * MiB;
constexpr size_t WS_WCAT = 13 * MiB;
constexpr size_t WS_WO = 15 * MiB;
constexpr size_t WS_WGU = 17 * MiB;
constexpr size_t WS_WD = 145 * MiB;
constexpr size_t WS_PROJ = 209 * MiB;
constexpr size_t WS_SMALL = 561 * MiB;
constexpr size_t WS_KI = 563 * MiB;
constexpr size_t WS_NL = 567 * MiB;
constexpr size_t WS_MLBE = WS_NL + 512 * 1024;
constexpr size_t WS_TOK = 568 * MiB;
constexpr size_t WS_GATE = 572 * MiB;
constexpr size_t WS_PAIR = 576 * MiB;
constexpr size_t WS_R1 = 584 * MiB;
constexpr size_t WS_R3 = 712 * MiB;
constexpr size_t WS_XB = WS_R3;
constexpr size_t WS_MW = WS_R3;
constexpr size_t WS_YCAT = WS_R3 + 16 * MiB;
constexpr size_t WS_MIX = WS_R3 + 80 * MiB;
constexpr size_t WS_CL = WS_R3 + 144 * MiB;
constexpr size_t WS_QC = WS_R3 + 208 * MiB;
constexpr size_t WS_KC = WS_R3 + 224 * MiB;
constexpr size_t WS_Y2 = WS_R3;
constexpr size_t WS_END = 984 * MiB;
constexpr int CW_CNT = 64;
constexpr int CW_BAR = 4096;

constexpr int LDS_MISC = 150 * 1024;
constexpr int LDS_BYTES = 152 * 1024;

#define GAS __attribute__((address_space(1)))
#define LAS __attribute__((address_space(3)))
typedef unsigned short bf16_t;
typedef short bf16x8 __attribute__((ext_vector_type(8)));
typedef short s16x4 __attribute__((ext_vector_type(4)));
typedef float f32x4 __attribute__((ext_vector_type(4)));
typedef float f32x2 __attribute__((ext_vector_type(2)));
typedef float f32x16 __attribute__((ext_vector_type(16)));
typedef unsigned u32x4 __attribute__((ext_vector_type(4)));
typedef unsigned u32x2 __attribute__((ext_vector_type(2)));

__device__ __forceinline__ unsigned cvt_pk_bf16(float lo, float hi) { unsigned r; asm("v_cvt_pk_bf16_f32 %0, %1, %2" : "=v"(r) : "v"(lo), "v"(hi)); return r; }
__device__ __forceinline__ float bf2f(unsigned short b) { return __uint_as_float(((unsigned)b) << 16); }
__device__ __forceinline__ float bflo(unsigned w) { return __uint_as_float(w << 16); }
__device__ __forceinline__ float bfhi(unsigned w) { return __uint_as_float(w & 0xffff0000u); }
__device__ __forceinline__ unsigned short f2bf(float f) { return (unsigned short)(cvt_pk_bf16(f, 0.f) & 0xffffu); }
__device__ __forceinline__ float sigmoidf_(float x) { return __builtin_amdgcn_rcpf(1.f + __expf(-x)); }
__device__ __forceinline__ float wave_sum(float v) {
#pragma unroll
    for (int o = 1; o < 64; o <<= 1) v += __shfl_xor(v, o);
    return v;
}
__device__ __forceinline__ float wave_max(float v) {
#pragma unroll
    for (int o = 1; o < 64; o <<= 1) v = fmaxf(v, __shfl_xor(v, o));
    return v;
}

#define XB_TMO      128
#define XB_XCNT(j)  (256  + 64 * (j))
#define XB_XSUB(j)  (1280 + 64 * (j))
#define XB_XGEN(j)  (2304 + 64 * (j))
#define XB_TOP      3328
#define XB_TOPGEN   3392
#define XCD_BAR_WORDS 3456
#define XB_SPIN_CAP (1u << 18)
__device__ __forceinline__ unsigned xb_ld(unsigned* p)              { return __hip_atomic_load(p, __ATOMIC_RELAXED, __HIP_MEMORY_SCOPE_AGENT); }
__device__ __forceinline__ unsigned xb_add(unsigned* p, unsigned v) { return __hip_atomic_fetch_add(p, v, __ATOMIC_RELAXED, __HIP_MEMORY_SCOPE_AGENT); }
__device__ __forceinline__ unsigned xb_xcc_id() { return (unsigned)__builtin_amdgcn_s_getreg((3 << 11) | 20) & 0xFu; }
#define XB_SPIN(cond, bar) do { unsigned _sp = 0; while (cond) { __builtin_amdgcn_s_sleep(1); \
    if ((++_sp & 255u) == 0u) { if (xb_ld(&(bar)[XB_TMO])) break; if (_sp > XB_SPIN_CAP) { atomicAdd(&(bar)[XB_TMO], 1u); break; } } } } while (0)
struct XcdBarrier { unsigned* bar; unsigned x; volatile LAS unsigned* st; };
__device__ __forceinline__ XcdBarrier xcd_barrier_post(unsigned* bar, volatile LAS unsigned* st) {
    XcdBarrier b; b.bar = bar; b.x = xb_xcc_id(); b.st = st;
    if (threadIdx.x == 0) (void)xb_add(&bar[XB_XCNT(b.x)], 1u);
    return b;
}
__device__ __forceinline__ void xcd_barrier_complete(unsigned* bar, unsigned x, unsigned& nloc, unsigned& nx) {
    const unsigned G = gridDim.x * gridDim.y * gridDim.z;
    unsigned sum, cnt, mine, sp = 0u;
    for (;;) {
        sum = 0u; cnt = 0u; mine = 0u;
#pragma unroll
        for (unsigned j = 0; j < 16; ++j) { const unsigned c = xb_ld(&bar[XB_XCNT(j)]); sum += c; cnt += (c > 0u) ? 1u : 0u; mine = (j == x) ? c : mine; }
        if (sum == G) break;
        __builtin_amdgcn_s_sleep(1);
        if ((++sp & 255u) == 0u) { if (xb_ld(&bar[XB_TMO])) break; if (sp > XB_SPIN_CAP) { atomicAdd(&bar[XB_TMO], 1u); break; } }
    }
    nloc = mine > 0u ? mine : 1u; nx = cnt > 0u ? cnt : 1u;
}
__device__ __forceinline__ void xcd_barrier(const XcdBarrier& b) {
    asm volatile("s_waitcnt vmcnt(0)" ::: "memory");
    __syncthreads();
    if (threadIdx.x == 0) {
        unsigned* bar = b.bar;
        __builtin_amdgcn_s_waitcnt(0);
        unsigned nloc = b.st[0], nx = b.st[1];
        if (nloc == 0u) { xcd_barrier_complete(bar, b.x, nloc, nx); b.st[0] = nloc; b.st[1] = nx; }
        const unsigned old = xb_add(&bar[XB_XSUB(b.x)], 1u);
        const unsigned gen = old / nloc;
        if (old + 1u == (gen + 1u) * nloc) {
            __builtin_amdgcn_fence(__ATOMIC_RELEASE, "agent");
            asm volatile("s_waitcnt vmcnt(0)" ::: "memory");
            const unsigned og = xb_add(&bar[XB_TOP], 1u);
            const unsigned tg = og / nx;
            if (og + 1u == (tg + 1u) * nx) xb_add(&bar[XB_TOPGEN], 1u);
            else XB_SPIN(xb_ld(&bar[XB_TOPGEN]) == tg, bar);
            __builtin_amdgcn_fence(__ATOMIC_ACQUIRE, "agent");
            xb_add(&bar[XB_XGEN(b.x)], 1u);
            asm volatile("s_waitcnt vmcnt(0)" ::: "memory");
        } else {
            XB_SPIN(xb_ld(&bar[XB_XGEN(b.x)]) == gen, bar);
            __builtin_amdgcn_fence(__ATOMIC_ACQUIRE, "agent");
            asm volatile("s_waitcnt vmcnt(0)" ::: "memory");
        }
    }
    __syncthreads();
}

struct Frame {
    LAS unsigned char* lds;
    unsigned char* ws;
    int tid, lane, wave, G, bid;
    const float *x, *w_in, *conv_w, *conv_b, *i_bias, *f_bias, *norm_g, *w_ba, *w_bm, *w_out, *ln1_g, *ln1_b, *w_router, *b_router,
                *w_gu, *b_gu, *w_down, *b_down, *ln2_g, *ln2_b, *rel_bias;
    float* out;
};

namespace pg8 {
constexpr int BM = 256, BK = 64, HALF = 128, HTB = HALF * BK * 2, STAGE_BYTES = 8 * HTB, NXCD = 8, WGM = 8;
__host__ __device__ __forceinline__ int lds_byte(int r, int c) { const int st = (r >> 4) * 2 + (c >> 5), rr = r & 15, cc = c & 31, ob = rr * 64 + cc * 2; return st * 1024 + (ob ^ (((ob >> 9) & 1) << 5)); }
__host__ __device__ __forceinline__ void stage_rc(int b, int& R, int& C) { const int st = b / 1024, sb = b % 1024, swz = sb ^ (((sb >> 9) & 1) << 5); R = (st >> 1) * 16 + swz / 64; C = (st & 1) * 32 + (swz % 64) / 2; }
__host__ __device__ __forceinline__ int perm32(int rho) { const int n = rho >> 4, i = rho & 15; return 8 * (i >> 2) + 4 * n + (i & 3); }

struct Unit { int pm, pn, e, rt, nv; };

__device__ __forceinline__ void tile_of(int L, int nM, int nN, int& pm, int& pn) {
    const int nwg = nM * nN; int wgid = L;
    { const int q = nwg / NXCD, r = nwg % NXCD, xcd = wgid % NXCD, off = wgid / NXCD; wgid = (xcd < r ? xcd * (q + 1) : r * (q + 1) + (xcd - r) * q) + off; }
    const int nig = WGM * nN, gid = wgid / nig, fm = gid * WGM, gsz = (nM - fm) < WGM ? (nM - fm) : WGM;
    pm = fm + ((wgid % nig) % gsz); pn = (wgid % nig) / gsz;
}
struct DenseOrder {
    const char* A; const char* Bt; int lda, K, nM, nN, G, c;
    __device__ __forceinline__ bool next(int i, Unit& u) const { const long L = (long)i * G + c; if (L >= (long)nM * nN) return false; tile_of((int)L, nM, nN, u.pm, u.pn); u.e = 0; u.rt = 0; u.nv = 256; return true; }
    __device__ __forceinline__ const char* abase() const { return A; }
    __device__ __forceinline__ const char* bbase(const Unit& u) const { return Bt + (size_t)u.pn * 256 * K * 2; }
    __device__ __forceinline__ void aoffs(const Unit& u, const int (&R)[2], const int (&C)[2], unsigned (&vo)[2][2]) const {
#pragma unroll
        for (int h = 0; h < 2; ++h)
#pragma unroll
            for (int i = 0; i < 2; ++i) vo[h][i] = (unsigned)((u.pm * 256 + h * 128 + R[i]) * lda + C[i]) * 2u;
    }
};
struct MergeOrder {
    const char* A; const char* Bt; int G, c;
    __device__ __forceinline__ bool next(int i, Unit& u) const { const long L = (long)(i >> 1) * G + c; if (L >= 512) return false; tile_of((int)L, 128, 4, u.pm, u.pn); u.e = i & 1; u.rt = 0; u.nv = 256; return true; }
    __device__ __forceinline__ const char* abase() const { return A; }
    __device__ __forceinline__ const char* bbase(const Unit& u) const { return Bt + (size_t)u.e * 1024 * 512 * 2 + (size_t)u.pn * 256 * 512 * 2; }
    __device__ __forceinline__ void aoffs(const Unit& u, const int (&R)[2], const int (&C)[2], unsigned (&vo)[2][2]) const {
#pragma unroll
        for (int h = 0; h < 2; ++h)
#pragma unroll
            for (int i = 0; i < 2; ++i) vo[h][i] = (unsigned)((u.pm * 256 + h * 128 + R[i]) * 1024 + u.e * 512 + C[i]) * 2u;
    }
};
struct MoeOrder {
    const LAS int* tstart; const LAS int* cnt; const char* A; const char* Bt; const int* tok; int nct, G, c; size_t bstride; bool gather;
    __device__ __forceinline__ bool next(int i, Unit& u) const {
        const long L = (long)i * G + c; const int ntile = tstart[32]; if (L >= (long)ntile * nct) return false;
        const int gt = (int)(L / nct); int e = 0;
#pragma unroll
        for (int s = 16; s >= 1; s >>= 1) if (tstart[e + s] <= gt) e += s;
        u.pm = gt; u.pn = (int)(L % nct); u.e = e; u.rt = gt - tstart[e]; const int rem = cnt[e] - u.rt * 256; u.nv = rem < 256 ? rem : 256; return true;
    }
    __device__ __forceinline__ const char* abase() const { return A; }
    __device__ __forceinline__ const char* bbase(const Unit& u) const { return Bt + (size_t)u.e * bstride + (size_t)u.pn * 256 * 1024 * 2; }
    __device__ __forceinline__ void aoffs(const Unit& u, const int (&R)[2], const int (&C)[2], unsigned (&vo)[2][2]) const {
#pragma unroll
        for (int h = 0; h < 2; ++h)
#pragma unroll
            for (int i = 0; i < 2; ++i) {
                const int r = h * 128 + R[i]; int row;
                if (gather) { row = (r < u.nv) ? tok[u.e * ECAP + u.rt * 256 + r] : 0; } else row = u.pm * 256 + r;
                vo[h][i] = (unsigned)(row * 1024 + C[i]) * 2u;
            }
    }
};

template <class Epi, class Sched>
__device__ __forceinline__ void gemm_phase(LAS unsigned char* lds, const int K, const Sched& S, const Epi& E) {
    const int tid = threadIdx.x, wid = __builtin_amdgcn_readfirstlane(tid >> 6), lane = tid & 63, wr = wid >> 2, wc = wid & 3, fr = lane & 15, fq = lane >> 4;
    const int nt = K / BK;
    int Rr[2], Cc[2]; unsigned voffB[2];
#pragma unroll
    for (int i = 0; i < 2; ++i) { int R, C; stage_rc(tid * 16 + i * 8192, R, C); const int Rb = Epi::PERM ? ((R & ~31) + perm32(R & 31)) : R; Rr[i] = R; Cc[i] = C; voffB[i] = (unsigned)(Rb * K + C) * 2u; }
    const size_t kstep = (size_t)(BK * 2);
    const size_t hstep = (size_t)HALF * K * 2;
    const unsigned ldsw = (unsigned)wid * 1024u;
    const int aoff = lds_byte(wr * 64 + fr, fq * 8), boff = lds_byte(wc * 32 + fr, fq * 8);
#define PG8_SA(b, h) (((b) * 2 + (h)) * HTB)
#define PG8_SB(b, h) ((4 + (b) * 2 + (h)) * HTB)
#define PG8_STAGEB(bufoff, gbase) do { _Pragma("unroll") for (int _i = 0; _i < 2; ++_i) \
        __builtin_amdgcn_global_load_lds((const unsigned*)((const char*)(gbase) + voffB[_i]), (LAS unsigned*)(lds + (bufoff) + ldsw + _i * 8192), 16, 0, 0); } while (0)
#define PG8_STAGEA(bufoff, kofs, v0, v1) do { \
        __builtin_amdgcn_global_load_lds((const unsigned*)(Ab + (kofs) + (v0)), (LAS unsigned*)(lds + (bufoff) + ldsw), 16, 0, 0); \
        __builtin_amdgcn_global_load_lds((const unsigned*)(Ab + (kofs) + (v1)), (LAS unsigned*)(lds + (bufoff) + ldsw + 8192), 16, 0, 0); } while (0)
#define PG8_LDA(dst, b, h) do { _Pragma("unroll") for (int m = 0; m < 4; ++m) _Pragma("unroll") for (int k = 0; k < 2; ++k) dst[m][k] = *(const LAS bf16x8*)(lds + PG8_SA(b, h) + aoff + m * 2048 + k * 1024); } while (0)
#define PG8_LDB(dst, b, h) do { _Pragma("unroll") for (int n = 0; n < 2; ++n) _Pragma("unroll") for (int k = 0; k < 2; ++k) dst[n][k] = *(const LAS bf16x8*)(lds + PG8_SB(b, h) + boff + n * 2048 + k * 1024); } while (0)
#define PG8_MMA(ai, bj, At, Bt) do { __builtin_amdgcn_s_setprio(1); _Pragma("unroll") for (int m = 0; m < 4; ++m) _Pragma("unroll") for (int n = 0; n < 2; ++n) _Pragma("unroll") for (int k = 0; k < 2; ++k) \
        acc[ai][bj][m][n] = __builtin_amdgcn_mfma_f32_16x16x32_bf16(Bt[n][k], At[m][k], acc[ai][bj][m][n], 0, 0, 0); __builtin_amdgcn_s_setprio(0); } while (0)
#define PG8_WAIT_V(n) asm volatile("s_waitcnt vmcnt(" #n ")" ::: "memory")
#define PG8_WAIT_L(n) asm volatile("s_waitcnt lgkmcnt(" #n ")" ::: "memory")
#define PG8_BAR __builtin_amdgcn_s_barrier()
#define PG8_SCHED __builtin_amdgcn_sched_barrier(0)
    Unit cur, nxt; int ui = 0;
    if (!S.next(0, cur)) return;
    f32x4 acc[2][2][4][2];
#pragma unroll
    for (int a = 0; a < 2; ++a)
#pragma unroll
        for (int b = 0; b < 2; ++b)
#pragma unroll
            for (int m = 0; m < 4; ++m)
#pragma unroll
                for (int n = 0; n < 2; ++n) acc[a][b][m][n] = (f32x4){0.f, 0.f, 0.f, 0.f};
    bf16x8 At[4][2], B0[2][2], B1[2][2];
    const char* Ab = S.abase();
    unsigned voC[2][2], voN[2][2];
    S.aoffs(cur, Rr, Cc, voC);
    const char* cB = S.bbase(cur);
    PG8_STAGEB(PG8_SB(0, 0), cB); PG8_STAGEA(PG8_SA(0, 0), 0, voC[0][0], voC[0][1]); PG8_STAGEB(PG8_SB(0, 1), cB + hstep); PG8_STAGEA(PG8_SA(0, 1), 0, voC[1][0], voC[1][1]);
    if (wr == 1) PG8_BAR;
    PG8_WAIT_V(4); PG8_BAR;
    PG8_STAGEB(PG8_SB(1, 0), cB + kstep); PG8_STAGEA(PG8_SA(1, 0), kstep, voC[0][0], voC[0][1]); PG8_STAGEB(PG8_SB(1, 1), cB + hstep + kstep);
    PG8_WAIT_V(6); PG8_BAR;
    for (;;) {
        const bool has_next = S.next(ui + 1, nxt);
        if (has_next) S.aoffs(nxt, Rr, Cc, voN);
        else {
#pragma unroll
            for (int h = 0; h < 2; ++h)
#pragma unroll
                for (int i = 0; i < 2; ++i) voN[h][i] = voC[h][i];
        }
        const char* nB = has_next ? S.bbase(nxt) : cB;
        for (int t = 0; t < nt; t += 2) {
            const bool last = (t == nt - 2);
            const size_t k1 = (size_t)(t + 1) * kstep;
            const size_t k2 = last ? 0 : (size_t)(t + 2) * kstep, k3 = k2 + kstep;
            const char* b2 = last ? nB : cB + (size_t)(t + 2) * kstep; const char* b3 = b2 + kstep;
            const unsigned a00 = last ? voN[0][0] : voC[0][0], a01 = last ? voN[0][1] : voC[0][1], a10 = last ? voN[1][0] : voC[1][0], a11 = last ? voN[1][1] : voC[1][1];
            PG8_LDB(B0, 0, 0); PG8_SCHED; PG8_LDA(At, 0, 0); PG8_STAGEA(PG8_SA(1, 1), k1, voC[1][0], voC[1][1]);
            PG8_WAIT_L(8); PG8_BAR; PG8_WAIT_L(0); PG8_MMA(0, 0, At, B0); PG8_BAR; PG8_SCHED;
            PG8_LDB(B1, 0, 1); PG8_STAGEB(PG8_SB(0, 0), b2);
            PG8_BAR; PG8_WAIT_L(0); PG8_MMA(0, 1, At, B1); PG8_BAR;
            PG8_LDA(At, 0, 1); PG8_STAGEA(PG8_SA(0, 0), k2, a00, a01);
            PG8_BAR; PG8_WAIT_L(0); PG8_MMA(1, 0, At, B0); PG8_BAR; PG8_SCHED;
            PG8_STAGEB(PG8_SB(0, 1), b2 + hstep);
            PG8_WAIT_V(6); PG8_BAR; PG8_MMA(1, 1, At, B1); PG8_BAR;
            PG8_LDB(B0, 1, 0); PG8_SCHED; PG8_LDA(At, 1, 0); PG8_STAGEA(PG8_SA(0, 1), k2, a10, a11);
            PG8_WAIT_L(8); PG8_BAR; PG8_WAIT_L(0); PG8_MMA(0, 0, At, B0); PG8_BAR; PG8_SCHED;
            PG8_LDB(B1, 1, 1); PG8_STAGEB(PG8_SB(1, 0), b3);
            PG8_BAR; PG8_WAIT_L(0); PG8_MMA(0, 1, At, B1); PG8_BAR;
            PG8_LDA(At, 1, 1); PG8_STAGEA(PG8_SA(1, 0), k3, a00, a01);
            PG8_BAR; PG8_WAIT_L(0); PG8_MMA(1, 0, At, B0); PG8_BAR; PG8_SCHED;
            PG8_STAGEB(PG8_SB(1, 1), b3 + hstep);
            PG8_WAIT_V(6); PG8_BAR; PG8_MMA(1, 1, At, B1); PG8_BAR;
        }
        E(acc, cur, wr, wc, fr, fq);
        if (!has_next) break;
#pragma unroll
        for (int a = 0; a < 2; ++a)
#pragma unroll
            for (int b = 0; b < 2; ++b)
#pragma unroll
                for (int m = 0; m < 4; ++m)
#pragma unroll
                    for (int n = 0; n < 2; ++n) acc[a][b][m][n] = (f32x4){0.f, 0.f, 0.f, 0.f};
        cur = nxt; cB = nB; ++ui;
#pragma unroll
        for (int h = 0; h < 2; ++h)
#pragma unroll
            for (int i = 0; i < 2; ++i) voC[h][i] = voN[h][i];
    }
    PG8_WAIT_V(0);
    if (wr == 0) PG8_BAR;
    PG8_BAR;
#undef PG8_SA
#undef PG8_SB
#undef PG8_STAGEA
#undef PG8_STAGEB
#undef PG8_LDA
#undef PG8_LDB
#undef PG8_MMA
#undef PG8_WAIT_V
#undef PG8_WAIT_L
#undef PG8_BAR
#undef PG8_SCHED
}
}
using pg8::Unit;

struct EpiProj {
    static constexpr bool PERM = true;
    bf16_t* proj; bf16_t* ki; float* small_;
    __device__ __forceinline__ void operator()(const f32x4 (&acc)[2][2][4][2], const Unit& u, int wr, int wc, int fr, int fq) const {
        const int row0 = u.pm * 256 + wr * 64 + fr;
        if (u.pn < 22) {
            const int col0 = u.pn * 256 + wc * 32 + 8 * fq;
#pragma unroll
            for (int ai = 0; ai < 2; ++ai)
#pragma unroll
                for (int m = 0; m < 4; ++m) { bf16_t* rowp = proj + (size_t)(row0 + ai * 128 + m * 16) * NPJ + col0;
#pragma unroll
                    for (int bj = 0; bj < 2; ++bj) { const f32x4 v0 = acc[ai][bj][m][0], v1 = acc[ai][bj][m][1];
                        u32x4 w; w.x = cvt_pk_bf16(v0[0], v0[1]); w.y = cvt_pk_bf16(v0[2], v0[3]); w.z = cvt_pk_bf16(v1[0], v1[1]); w.w = cvt_pk_bf16(v1[2], v1[3]);
                        *(u32x4*)(rowp + bj * 128) = w; } }
        } else {
#pragma unroll
            for (int ai = 0; ai < 2; ++ai)
#pragma unroll
                for (int m = 0; m < 4; ++m) { const int row = row0 + ai * 128 + m * 16; const f32x4 v0 = acc[ai][0][m][0], v1 = acc[ai][0][m][1];
                    if (wc < 2) { u32x4 w; w.x = cvt_pk_bf16(v0[0], v0[1]); w.y = cvt_pk_bf16(v0[2], v0[3]); w.z = cvt_pk_bf16(v1[0], v1[1]); w.w = cvt_pk_bf16(v1[2], v1[3]);
                        *(u32x4*)(ki + (size_t)row * 64 + wc * 32 + 8 * fq) = w; }
                    else if (wc == 2 && fq < 2) { *(f32x4*)(small_ + (size_t)row * 16 + 8 * fq) = v0; *(f32x4*)(small_ + (size_t)row * 16 + 8 * fq + 4) = v1; } }
        }
    }
};
struct EpiMerge {
    static constexpr bool PERM = true;
    const bf16_t* proj; bf16_t* mix;
    __device__ __forceinline__ void operator()(const f32x4 (&acc)[2][2][4][2], const Unit& u, int wr, int wc, int fr, int fq) const {
        const int row0 = u.pm * 256 + wr * 64 + fr, col0 = u.pn * 256 + wc * 32 + 8 * fq; const int gcol = (u.e ? C_GM : C_GA) + col0;
#pragma unroll
        for (int ai = 0; ai < 2; ++ai)
#pragma unroll
            for (int m = 0; m < 4; ++m) { const int row = row0 + ai * 128 + m * 16;
#pragma unroll
                for (int bj = 0; bj < 2; ++bj) {
                    const u32x4 g = *(const u32x4*)(proj + (size_t)row * NPJ + gcol + bj * 128);
                    bf16_t* mp = mix + (size_t)row * 1024 + col0 + bj * 128;
                    u32x4 old = (u32x4){0u, 0u, 0u, 0u}; if (u.e) old = *(const u32x4*)mp;
                    const f32x4 v0 = acc[ai][bj][m][0], v1 = acc[ai][bj][m][1];
                    float o[8];
                    o[0] = bflo(old.x) + sigmoidf_(bflo(g.x)) * v0[0]; o[1] = bfhi(old.x) + sigmoidf_(bfhi(g.x)) * v0[1];
                    o[2] = bflo(old.y) + sigmoidf_(bflo(g.y)) * v0[2]; o[3] = bfhi(old.y) + sigmoidf_(bfhi(g.y)) * v0[3];
                    o[4] = bflo(old.z) + sigmoidf_(bflo(g.z)) * v1[0]; o[5] = bfhi(old.z) + sigmoidf_(bfhi(g.z)) * v1[1];
                    o[6] = bflo(old.w) + sigmoidf_(bflo(g.w)) * v1[2]; o[7] = bfhi(old.w) + sigmoidf_(bfhi(g.w)) * v1[3];
                    u32x4 w; w.x = cvt_pk_bf16(o[0], o[1]); w.y = cvt_pk_bf16(o[2], o[3]); w.z = cvt_pk_bf16(o[4], o[5]); w.w = cvt_pk_bf16(o[6], o[7]);
                    *(u32x4*)mp = w; } }
    }
};
struct EpiOut {
    static constexpr bool PERM = false;
    const float* x; float* z;
    __device__ __forceinline__ void operator()(const f32x4 (&acc)[2][2][4][2], const Unit& u, int wr, int wc, int fr, int fq) const {
        const int row0 = u.pm * 256 + wr * 64 + fr, col0 = u.pn * 256 + wc * 32 + 4 * fq;
#pragma unroll
        for (int ai = 0; ai < 2; ++ai)
#pragma unroll
            for (int m = 0; m < 4; ++m) { const size_t off = (size_t)(row0 + ai * 128 + m * 16) * 1024 + col0;
#pragma unroll
                for (int bj = 0; bj < 2; ++bj)
#pragma unroll
                    for (int n = 0; n < 2; ++n) { const f32x4 xv = *(const f32x4*)(x + off + bj * 128 + n * 16); *(f32x4*)(z + off + bj * 128 + n * 16) = xv * DN_ALPHA + acc[ai][bj][m][n]; } }
    }
};
struct EpiGateUp {
    static constexpr bool PERM = true;
    const float* bgu; bf16_t* h;
    __device__ __forceinline__ void operator()(const f32x4 (&acc)[2][2][4][2], const Unit& u, int wr, int wc, int fr, int fq) const {
        const int row0 = u.pm * 256 + wr * 64 + fr, ff0 = u.pn * 128 + wc * 32 + 8 * fq; const float* bg = bgu + (size_t)u.e * 2048 + ff0;
        f32x4 bgate[2], bup[2];
#pragma unroll
        for (int n = 0; n < 2; ++n) { bgate[n] = *(const f32x4*)(bg + 4 * n); bup[n] = *(const f32x4*)(bg + 1024 + 4 * n); }
#pragma unroll
        for (int ai = 0; ai < 2; ++ai)
#pragma unroll
            for (int m = 0; m < 4; ++m) { float o[8];
#pragma unroll
                for (int n = 0; n < 2; ++n) { const f32x4 gt = acc[ai][0][m][n] + bgate[n], up = acc[ai][1][m][n] + bup[n];
#pragma unroll
                    for (int j = 0; j < 4; ++j) { const float g = fminf(gt[j], 7.0f), uu = fminf(fmaxf(up[j], -7.0f), 7.0f); o[4 * n + j] = (uu + 1.0f) * (g * sigmoidf_(1.702f * g)); } }
                u32x4 w; w.x = cvt_pk_bf16(o[0], o[1]); w.y = cvt_pk_bf16(o[2], o[3]); w.z = cvt_pk_bf16(o[4], o[5]); w.w = cvt_pk_bf16(o[6], o[7]);
                *(u32x4*)(h + (size_t)(row0 + ai * 128 + m * 16) * 1024 + ff0) = w; }
    }
};
struct EpiDown {
    static constexpr bool PERM = true;
    const float* bd; const float* gate; bf16_t* y2;
    __device__ __forceinline__ void operator()(const f32x4 (&acc)[2][2][4][2], const Unit& u, int wr, int wc, int fr, int fq) const {
        const int rl0 = wr * 64 + fr, col0 = u.pn * 256 + wc * 32 + 8 * fq; const float* bp = bd + (size_t)u.e * 1024 + col0;
        f32x4 bv[2][2];
#pragma unroll
        for (int bj = 0; bj < 2; ++bj)
#pragma unroll
            for (int n = 0; n < 2; ++n) bv[bj][n] = *(const f32x4*)(bp + bj * 128 + 4 * n);
#pragma unroll
        for (int ai = 0; ai < 2; ++ai)
#pragma unroll
            for (int m = 0; m < 4; ++m) { const int rl = rl0 + ai * 128 + m * 16; const float gr = (rl < u.nv) ? gate[(size_t)u.e * ECAP + u.rt * 256 + rl] : 0.f;
                bf16_t* rowp = y2 + (size_t)(u.pm * 256 + rl) * 1024 + col0;
#pragma unroll
                for (int bj = 0; bj < 2; ++bj) { const f32x4 v0 = (acc[ai][bj][m][0] + bv[bj][0]) * gr, v1 = (acc[ai][bj][m][1] + bv[bj][1]) * gr;
                    u32x4 w; w.x = cvt_pk_bf16(v0[0], v0[1]); w.y = cvt_pk_bf16(v0[2], v0[3]); w.z = cvt_pk_bf16(v1[0], v1[1]); w.w = cvt_pk_bf16(v1[2], v1[3]);
                    *(u32x4*)(rowp + bj * 128) = w; } }
    }
};

template <class SrcCol>
__device__ __forceinline__ void transpose_item(const float* W, int ldw, int K, bf16_t* WT, int n0, int k0, SrcCol sc, LAS float* scr, int lane) {
    const int c = sc(n0 + lane);
#pragma unroll 8
    for (int kk = 0; kk < 64; ++kk) scr[kk * 65 + lane] = (c >= 0) ? W[(size_t)(k0 + kk) * ldw + c] : 0.f;
    asm volatile("s_waitcnt lgkmcnt(0)" ::: "memory");
    const int ch = lane & 7;
#pragma unroll
    for (int j = 0; j < 8; ++j) { const int n = (lane >> 3) + 8 * j; const LAS float* s = scr + (8 * ch) * 65 + n;
        u32x4 o; o.x = cvt_pk_bf16(s[0 * 65], s[1 * 65]); o.y = cvt_pk_bf16(s[2 * 65], s[3 * 65]); o.z = cvt_pk_bf16(s[4 * 65], s[5 * 65]); o.w = cvt_pk_bf16(s[6 * 65], s[7 * 65]);
        *(u32x4*)(WT + (size_t)(n0 + n) * K + k0 + 8 * ch) = o; }
    asm volatile("s_waitcnt lgkmcnt(0)" ::: "memory");
}
__device__ __forceinline__ int win_srccol(int n) {
    if (n < 2048) return n;
    if (n < 2560) return n - 2048 + 2120;
    if (n < 3072) return n - 2560 + 2632;
    if (n < 3584) return n - 3072 + 3152;
    if (n < 5632) return n - 3584 + 3664;
    const int j = n - 5632;
    if (j < 64) return 2048 + j;
    if (j < 72) return 2112 + (j - 64);
    if (j < 76) return 3144 + (j - 72);
    if (j < 80) return 3148 + (j - 76);
    return -1;
}
__device__ __forceinline__ void p0_prologue(Frame& F) {
    LAS float* scr = (LAS float*)(F.lds + F.wave * 16640);
    const int gw = F.bid * 8 + F.wave, NGW = F.G * 8;
    constexpr int I_WIN = 16 * (NWIN / 64), I_CAT = 8 * 16, I_WO = 16 * 16, I_GU = 16 * 32, I_D = 16 * 16;
    constexpr int NITEMS = I_WIN + 2 * I_CAT + I_WO + NE * I_GU + NE * I_D;
    for (int it = gw; it < NITEMS; it += NGW) {
        int r = it;
        if (r < I_WIN) { const int nb = r % (NWIN / 64), kb = r / (NWIN / 64); transpose_item(F.w_in, 5712, 1024, (bf16_t*)(F.ws + WS_WIN), nb * 64, kb * 64, [](int n) { return win_srccol(n); }, scr, F.lane); continue; } r -= I_WIN;
        if (r < 2 * I_CAT) { const int wch = r / I_CAT; r -= wch * I_CAT; const int nb = r % 16, kb = r / 16;
            transpose_item(wch ? F.w_bm : F.w_ba, 1024, 512, (bf16_t*)(F.ws + WS_WCAT) + (size_t)wch * 1024 * 512, nb * 64, kb * 64, [](int n) { return n; }, scr, F.lane); continue; } r -= 2 * I_CAT;
        if (r < I_WO) { const int nb = r % 16, kb = r / 16; transpose_item(F.w_out, 1024, 1024, (bf16_t*)(F.ws + WS_WO), nb * 64, kb * 64, [](int n) { return n; }, scr, F.lane); continue; } r -= I_WO;
        if (r < NE * I_GU) { const int e = r / I_GU; r -= e * I_GU; const int nb = r % 32, kb = r / 32;
            transpose_item(F.w_gu + (size_t)e * 1024 * 2048, 2048, 1024, (bf16_t*)(F.ws + WS_WGU) + (size_t)e * 2048 * 1024, nb * 64, kb * 64,
                           [](int n) { return ((n >> 7) & 1) * 1024 + (n >> 8) * 128 + (n & 127); }, scr, F.lane); continue; } r -= NE * I_GU;
        { const int e = r / I_D; r -= e * I_D; const int nb = r % 16, kb = r / 16;
            transpose_item(F.w_down + (size_t)e * 1024 * 1024, 1024, 1024, (bf16_t*)(F.ws + WS_WD) + (size_t)e * 1024 * 1024, nb * 64, kb * 64, [](int n) { return n; }, scr, F.lane); }
    }
    const f32x4* xs = (const f32x4*)F.x; u32x4* xd = (u32x4*)(F.ws + WS_XB);
    for (size_t i = (size_t)F.bid * 512 + F.tid; i < (size_t)T * 1024 / 8; i += (size_t)F.G * 512) {
        const f32x4 a = xs[2 * i], b = xs[2 * i + 1]; u32x4 w; w.x = cvt_pk_bf16(a[0], a[1]); w.y = cvt_pk_bf16(a[2], a[3]); w.z = cvt_pk_bf16(b[0], b[1]); w.w = cvt_pk_bf16(b[2], b[3]); xd[i] = w; }
}

__device__ __forceinline__ unsigned score_key(float v) { unsigned u = __float_as_uint(v); if (u == 0x80000000u) u = 0u; return (u & 0x80000000u) ? ~u : (u | 0x80000000u); }
__device__ __forceinline__ int crow(int r, int hi) { return (r & 3) + 8 * (r >> 2) + 4 * hi; }

template <int NVT>
__device__ __forceinline__ unsigned long long select_query(const float* row, int t, int lane) {
    unsigned key[NVT];
#pragma unroll
    for (int j = 0; j < NVT; ++j) { const int s = 64 * j + lane; float v = 0.f; if (s <= t) v = row[s]; key[j] = (s <= t) ? score_key(v) : 0u; }
    unsigned thr = 0u; int need = 0;
    if (t >= 256) {
        for (int bit = 31; bit >= 0; --bit) {
            const unsigned cand = thr | (1u << bit); int c = 0;
#pragma unroll
            for (int j = 0; j < NVT; ++j) c += __popcll(__ballot(key[j] >= cand));
            if (c >= 256) thr = cand;
        }
        int cg = 0;
#pragma unroll
        for (int j = 0; j < NVT; ++j) cg += __popcll(__ballot(key[j] > thr));
        need = 256 - cg;
    }
    unsigned long long myword = 0ull; int eq_seen = 0;
#pragma unroll
    for (int j = 0; j < NVT; ++j) {
        bool sel;
        if (t >= 256) { const bool gt = key[j] > thr, eq = key[j] == thr; const unsigned long long bm = __ballot(eq);
            const int rank = eq_seen + (int)__builtin_amdgcn_mbcnt_hi((unsigned)(bm >> 32), __builtin_amdgcn_mbcnt_lo((unsigned)bm, 0u)); sel = gt || (eq && rank < need); eq_seen += __popcll(bm); }
        else sel = (64 * j + lane) <= t;
        const unsigned long long w = __ballot(sel);
        if (lane == j) myword = w;
    }
    return myword;
}

__device__ __forceinline__ void idx_unit(Frame& F, int b, int qb) {
    const bf16_t* proj = (const bf16_t*)(F.ws + WS_PROJ); const bf16_t* ki = (const bf16_t*)(F.ws + WS_KI); const float* small_ = (const float*)(F.ws + WS_SMALL);
    float* sc = (float*)(F.ws + WS_R1) + (size_t)F.bid * 32 * 4096;
    const int lane = F.lane, w = F.wave, qg = w & 3, kp = w >> 2, r32 = lane & 31, hi = lane >> 5;
    const int rowbase = b * SEQ, q0 = qb * 32;
    bf16x8 af[2][4];
    { const int tokq = rowbase + q0 + 8 * qg + (r32 >> 2);
#pragma unroll
      for (int ht = 0; ht < 2; ++ht)
#pragma unroll
          for (int ks = 0; ks < 4; ++ks) af[ht][ks] = *(const bf16x8*)(proj + (size_t)tokq * NPJ + C_QI + (4 * ht + (r32 & 3)) * 64 + 16 * ks + 8 * hi); }
    float wv[4][8];
#pragma unroll
    for (int g = 0; g < 4; ++g) { const float* wp = small_ + (size_t)(rowbase + q0 + 8 * qg + 2 * g + hi) * 16; const f32x4 a = *(const f32x4*)wp, bq = *(const f32x4*)(wp + 4);
        wv[g][0] = a[0]; wv[g][1] = a[1]; wv[g][2] = a[2]; wv[g][3] = a[3]; wv[g][4] = bq[0]; wv[g][5] = bq[1]; wv[g][6] = bq[2]; wv[g][7] = bq[3]; }
    const int nkt = qb + 1;
    for (int kt = kp; kt < nkt; kt += 2) {
        const bf16_t* kpz = ki + (size_t)(rowbase + kt * 32 + r32) * 64 + 8 * hi;
        bf16x8 bfr[4];
#pragma unroll
        for (int ks = 0; ks < 4; ++ks) bfr[ks] = *(const bf16x8*)(kpz + 16 * ks);
        f32x16 a0 = {0.f}, a1 = {0.f};
#pragma unroll
        for (int ks = 0; ks < 4; ++ks) { a0 = __builtin_amdgcn_mfma_f32_32x32x16_bf16(af[0][ks], bfr[ks], a0, 0, 0, 0); a1 = __builtin_amdgcn_mfma_f32_32x32x16_bf16(af[1][ks], bfr[ks], a1, 0, 0, 0); }
#pragma unroll
        for (int g = 0; g < 4; ++g) { float s = 0.f;
#pragma unroll
            for (int j = 0; j < 4; ++j) { s += wv[g][j] * fmaxf(a0[4 * g + j], 0.f); s += wv[g][4 + j] * fmaxf(a1[4 * g + j], 0.f); }
            sc[(size_t)(8 * qg + 2 * g + hi) * 4096 + kt * 32 + r32] = s; }
    }
    __syncthreads();
    LAS unsigned long long* lw = (LAS unsigned long long*)F.lds;
#pragma unroll 1
    for (int i = 0; i < 4; ++i) {
        const int ql = 4 * w + i, t = q0 + ql; const float* row = sc + (size_t)ql * 4096; unsigned long long word;
        if (t < 512) word = select_query<8>(row, t, lane);
        else if (t < 1024) word = select_query<16>(row, t, lane);
        else if (t < 2048) word = select_query<32>(row, t, lane);
        else word = select_query<64>(row, t, lane);
        lw[lane * 32 + ql] = ~word;
    }
    __syncthreads();
    { unsigned long long* mw = (unsigned long long*)(F.ws + WS_MW) + (size_t)(b * 128 + qb) * 2048;
      for (int i = F.tid; i < 2048; i += 512) mw[i] = lw[i]; }
    __syncthreads();
}

__device__ __forceinline__ float log_sigmoidf_(float x) { return fminf(x, 0.f) - log1pf(expf(-fabsf(x))); }
__device__ __forceinline__ float wave_incl_scan(float v, int lane) {
#pragma unroll
    for (int o = 1; o < 64; o <<= 1) { const float u = __shfl_up(v, o); if (lane >= o) v += u; }
    return v;
}
__device__ __forceinline__ void chunk_gates(Frame& F, int tb, int h, int lane, float& bcum, float& li) {
    const float* small_ = (const float*)(F.ws + WS_SMALL);
    const float fp = small_[(size_t)(tb + lane) * 16 + 12 + h] + F.f_bias[h];
    li = small_[(size_t)(tb + lane) * 16 + 8 + h] + F.i_bias[h];
    bcum = wave_incl_scan(log_sigmoidf_(fp), lane);
}
__device__ __forceinline__ int sperm(int s) { return (s & ~12) | ((s & 4) << 1) | ((s & 8) >> 1); }

__device__ __forceinline__ void mlstm_local_unit(Frame& F, int b, int c) {
    const bf16_t* proj = (const bf16_t*)(F.ws + WS_PROJ);
    bf16_t* qc = (bf16_t*)(F.ws + WS_QC); bf16_t* kc = (bf16_t*)(F.ws + WS_KC);
    float* cl = (float*)(F.ws + WS_CL); float* nl = (float*)(F.ws + WS_NL); float* mlbe = (float*)(F.ws + WS_MLBE);
    const int tid = F.tid, lane = F.lane, w = F.wave; const int tb = b * SEQ + c * 64; const int cidx = (b * 64 + c) * 4;
    LAS bf16_t* KT = (LAS bf16_t*)F.lds;
    LAS bf16_t* VT = (LAS bf16_t*)(F.lds + 36864);
    LAS float* WL = (LAS float*)(F.lds + 36864 + 73728);
    if (w < 4) { float bc, li; chunk_gates(F, tb, w, lane, bc, li);
        const float bend = __shfl(bc, 63); const float a = bend - bc + li; const float ml = wave_max(a);
        WL[w * 64 + lane] = __expf(a - ml);
        if (lane == 0) { mlbe[cidx + w] = ml; mlbe[2048 + cidx + w] = bend; } }
    for (int i = tid; i < 64 * 64; i += 512) { const int l = i >> 6, v8 = (i & 63) * 8; const bf16x8 vv = *(const bf16x8*)(proj + (size_t)(tb + l) * NPJ + C_VM + v8);
        const int hh = v8 >> 7, vl = v8 & 127;
#pragma unroll
        for (int j = 0; j < 8; ++j) VT[(hh * 128 + vl + j) * 72 + l] = (bf16_t)vv[j]; }
    __syncthreads();
    { const int ch = tid; const float w0 = F.conv_w[ch], w1 = F.conv_w[512 + ch], w2 = F.conv_w[1024 + ch], w3 = F.conv_w[1536 + ch], cb = F.conv_b[ch];
      const bf16_t* xp = proj + (size_t)tb * NPJ + C_QM + ch;
      float x0 = 0.f, x1 = 0.f, x2 = 0.f;
      if (c > 0) { x0 = bf2f(xp[-3 * NPJ]); x1 = bf2f(xp[-2 * NPJ]); x2 = bf2f(xp[-1 * NPJ]); }
      const bool isk = ch >= 256; const int kch = ch - 256, hh = kch >> 6, kd = kch & 63; float nacc = 0.f;
#pragma unroll 4
      for (int l = 0; l < 64; ++l) { const float x3 = bf2f(xp[(size_t)l * NPJ]); float y = cb + w0 * x0 + w1 * x1 + w2 * x2 + w3 * x3; y = y * sigmoidf_(y);
          x0 = x1; x1 = x2; x2 = x3;
          if (!isk) qc[(size_t)(tb + l) * 256 + ch] = f2bf(y);
          else { y *= 0.125f; const unsigned short yb = f2bf(y); kc[(size_t)(tb + l) * 256 + kch] = yb; const float wl = WL[hh * 64 + l]; const float wk = wl * bf2f(yb); nacc += wk; KT[(hh * 64 + kd) * 72 + l] = f2bf(wk); } }
      if (isk) nl[(size_t)(cidx + hh) * 64 + kd] = nacc; }
    __syncthreads();
    { const int hh = w >> 1, sub = w & 1, r32 = lane & 31, hi = lane >> 5;
#pragma unroll
      for (int kt = 0; kt < 2; ++kt)
#pragma unroll
          for (int vt = 0; vt < 2; ++vt) { f32x16 acc = {0.f};
#pragma unroll
              for (int ks = 0; ks < 4; ++ks) { const bf16x8 a = *(const LAS bf16x8*)(KT + (hh * 64 + 32 * kt + r32) * 72 + 16 * ks + 8 * hi);
                  const bf16x8 bb = *(const LAS bf16x8*)(VT + (hh * 128 + 64 * sub + 32 * vt + r32) * 72 + 16 * ks + 8 * hi);
                  acc = __builtin_amdgcn_mfma_f32_32x32x16_bf16(a, bb, acc, 0, 0, 0); }
              float* dst = cl + ((size_t)(cidx + hh) * 128 + 64 * sub + 32 * vt + r32) * 64 + 32 * kt + 4 * hi;
#pragma unroll
              for (int g = 0; g < 4; ++g) *(f32x4*)(dst + 8 * g) = (f32x4){acc[4 * g], acc[4 * g + 1], acc[4 * g + 2], acc[4 * g + 3]}; } }
    __syncthreads();
}

__device__ __forceinline__ void mlstm_scan(Frame& F) {
    float* cl = (float*)(F.ws + WS_CL); float* nl = (float*)(F.ws + WS_NL); float* mlbe = (float*)(F.ws + WS_MLBE);
    constexpr int PER = 8192 + 64, TOTAL = 32 * PER;
    for (int e = F.bid * 512 + F.tid; e < TOTAL; e += F.G * 512) {
        const int bh = e / PER, off = e % PER, b = bh >> 2, h = bh & 3;
        float m = 0.f, st = 0.f;
#pragma unroll 1
        for (int cb = 0; cb < 8; ++cb) {
            float v[8], ml[8], be[8];
#pragma unroll
            for (int j = 0; j < 8; ++j) { const int idx = (b * 64 + cb * 8 + j) * 4 + h; float* p = (off < 8192) ? (cl + (size_t)idx * 8192 + off) : (nl + (size_t)idx * 64 + (off - 8192)); v[j] = *p; ml[j] = mlbe[idx]; be[j] = mlbe[2048 + idx]; }
#pragma unroll
            for (int j = 0; j < 8; ++j) { const int idx = (b * 64 + cb * 8 + j) * 4 + h; float* p = (off < 8192) ? (cl + (size_t)idx * 8192 + off) : (nl + (size_t)idx * 64 + (off - 8192));
                const float mn = fmaxf(be[j] + m, ml[j]); const float dec = __expf(be[j] + m - mn), inj = __expf(ml[j] - mn);
                *p = st; if (off == 0) mlbe[4096 + idx] = m;
                st = dec * st + inj * v[j]; m = mn; }
        }
    }
}

__device__ __forceinline__ void mlstm_out_unit(Frame& F, int b, int c) {
    const bf16_t* proj = (const bf16_t*)(F.ws + WS_PROJ);
    const bf16_t* qc = (const bf16_t*)(F.ws + WS_QC); const bf16_t* kc = (const bf16_t*)(F.ws + WS_KC);
    const float* cl = (const float*)(F.ws + WS_CL); const float* nl = (const float*)(F.ws + WS_NL); const float* mlbe = (const float*)(F.ws + WS_MLBE);
    bf16_t* ycat = (bf16_t*)(F.ws + WS_YCAT);
    const int tid = F.tid, lane = F.lane, w = F.wave; const int tb = b * SEQ + c * 64; const int cidx = (b * 64 + c) * 4;
    LAS bf16_t* VT = (LAS bf16_t*)F.lds;
    LAS float* BL = (LAS float*)(F.lds + 73728);
    LAS float* LI = BL + 256;
    LAS float* N0 = LI + 256;
    if (w < 4) { float bc, li; chunk_gates(F, tb, w, lane, bc, li); BL[w * 64 + lane] = bc; LI[w * 64 + lane] = li; N0[w * 64 + lane] = nl[(size_t)(cidx + w) * 64 + lane]; }
    for (int i = tid; i < 64 * 64; i += 512) { const int l = i >> 6, v8 = (i & 63) * 8; const bf16x8 vv = *(const bf16x8*)(proj + (size_t)(tb + l) * NPJ + C_VM + v8);
        const int hh = v8 >> 7, vl = v8 & 127, lp = sperm(l);
#pragma unroll
        for (int j = 0; j < 8; ++j) VT[(hh * 128 + vl + j) * 72 + lp] = (bf16_t)vv[j]; }
    __syncthreads();
    const int hh = w >> 1, sub = w & 1, r32 = lane & 31, hi = lane >> 5;
    const int tq = 32 * sub + r32;
    const float m0 = mlbe[4096 + cidx + hh];
    const float bt = BL[hh * 64 + tq];
    bf16x8 qf[4];
#pragma unroll
    for (int ks = 0; ks < 4; ++ks) qf[ks] = *(const bf16x8*)(qc + (size_t)(tb + tq) * 256 + hh * 64 + 16 * ks + 8 * hi);
    f32x16 sT[2]; sT[0] = (f32x16){0.f}; sT[1] = (f32x16){0.f};
#pragma unroll
    for (int st = 0; st < 2; ++st) if (st <= sub) {
#pragma unroll
        for (int ks = 0; ks < 4; ++ks) { const bf16x8 kf = *(const bf16x8*)(kc + (size_t)(tb + 32 * st + r32) * 256 + hh * 64 + 16 * ks + 8 * hi);
            sT[st] = __builtin_amdgcn_mfma_f32_32x32x16_bf16(kf, qf[ks], sT[st], 0, 0, 0); } }
    float mi = -INFINITY;
#pragma unroll
    for (int st = 0; st < 2; ++st)
#pragma unroll
        for (int r = 0; r < 16; ++r) { const int s = 32 * st + crow(r, hi); float d = -INFINITY; if (st <= sub && s <= tq) d = bt - BL[hh * 64 + s] + LI[hh * 64 + s]; mi = fmaxf(mi, d); }
    mi = fmaxf(mi, __shfl_xor(mi, 32));
    const float minter = bt + m0; const float mt = fmaxf(minter, mi);
    float psum = 0.f;
#pragma unroll
    for (int st = 0; st < 2; ++st)
#pragma unroll
        for (int r = 0; r < 16; ++r) { const int s = 32 * st + crow(r, hi); float d = -INFINITY; if (st <= sub && s <= tq) d = bt - BL[hh * 64 + s] + LI[hh * 64 + s];
            const float p = sT[st][r] * __expf(d - mt); sT[st][r] = p; psum += p; }
    psum += __shfl_xor(psum, 32);
    const float sci = __expf(minter - mt);
    float qn = 0.f;
#pragma unroll
    for (int ks = 0; ks < 4; ++ks)
#pragma unroll
        for (int j = 0; j < 8; ++j) qn += bf2f((unsigned short)qf[ks][j]) * N0[hh * 64 + 16 * ks + 8 * hi + j];
    qn += __shfl_xor(qn, 32);
    const float den = psum + sci * qn; const float rden = 1.0f / fmaxf(fabsf(den), __expf(-mt));
    bf16x8 pf[2][2];
#pragma unroll
    for (int st = 0; st < 2; ++st)
#pragma unroll
        for (int k2 = 0; k2 < 2; ++k2) { u32x4 pk; pk.x = cvt_pk_bf16(sT[st][8 * k2], sT[st][8 * k2 + 1]); pk.y = cvt_pk_bf16(sT[st][8 * k2 + 2], sT[st][8 * k2 + 3]);
            pk.z = cvt_pk_bf16(sT[st][8 * k2 + 4], sT[st][8 * k2 + 5]); pk.w = cvt_pk_bf16(sT[st][8 * k2 + 6], sT[st][8 * k2 + 7]); pf[st][k2] = __builtin_bit_cast(bf16x8, pk); }
    bf16x8 qs[4];
#pragma unroll
    for (int ks = 0; ks < 4; ++ks) { u32x4 pk;
        pk.x = cvt_pk_bf16(sci * bf2f((unsigned short)qf[ks][0]), sci * bf2f((unsigned short)qf[ks][1])); pk.y = cvt_pk_bf16(sci * bf2f((unsigned short)qf[ks][2]), sci * bf2f((unsigned short)qf[ks][3]));
        pk.z = cvt_pk_bf16(sci * bf2f((unsigned short)qf[ks][4]), sci * bf2f((unsigned short)qf[ks][5])); pk.w = cvt_pk_bf16(sci * bf2f((unsigned short)qf[ks][6]), sci * bf2f((unsigned short)qf[ks][7]));
        qs[ks] = __builtin_bit_cast(bf16x8, pk); }
    f32x16 o[4];
#pragma unroll
    for (int vt = 0; vt < 4; ++vt) { f32x16 acc = {0.f};
#pragma unroll
        for (int st = 0; st < 2; ++st) if (st <= sub) {
#pragma unroll
            for (int k2 = 0; k2 < 2; ++k2) { const bf16x8 a = *(const LAS bf16x8*)(VT + (hh * 128 + 32 * vt + r32) * 72 + 32 * st + 16 * k2 + 8 * hi);
                acc = __builtin_amdgcn_mfma_f32_32x32x16_bf16(a, pf[st][k2], acc, 0, 0, 0); } }
        const float* cp = cl + ((size_t)(cidx + hh) * 128 + 32 * vt + r32) * 64 + 8 * hi;
#pragma unroll
        for (int ks = 0; ks < 4; ++ks) { const f32x4 c0 = *(const f32x4*)(cp + 16 * ks), c1 = *(const f32x4*)(cp + 16 * ks + 4);
            u32x4 pk; pk.x = cvt_pk_bf16(c0[0], c0[1]); pk.y = cvt_pk_bf16(c0[2], c0[3]); pk.z = cvt_pk_bf16(c1[0], c1[1]); pk.w = cvt_pk_bf16(c1[2], c1[3]);
            acc = __builtin_amdgcn_mfma_f32_32x32x16_bf16(__builtin_bit_cast(bf16x8, pk), qs[ks], acc, 0, 0, 0); }
        o[vt] = acc; }
    float s1 = 0.f;
#pragma unroll
    for (int vt = 0; vt < 4; ++vt)
#pragma unroll
        for (int r = 0; r < 16; ++r) { o[vt][r] *= rden; s1 += o[vt][r]; }
    s1 += __shfl_xor(s1, 32); const float mu = s1 * (1.f / 128.f); float s2 = 0.f;
#pragma unroll
    for (int vt = 0; vt < 4; ++vt)
#pragma unroll
        for (int r = 0; r < 16; ++r) { const float d = o[vt][r] - mu; s2 += d * d; }
    s2 += __shfl_xor(s2, 32); const float rstd = 1.0f / sqrtf(s2 * (1.f / 128.f) + LN_EPS);
    const bf16_t* omp = proj + (size_t)(tb + tq) * NPJ + C_OM + hh * 128; bf16_t* yp = ycat + (size_t)(tb + tq) * 1024 + 512 + hh * 128; const float* ng = F.norm_g + hh * 128;
#pragma unroll
    for (int vt = 0; vt < 4; ++vt)
#pragma unroll
        for (int g = 0; g < 4; ++g) { const int v0 = 32 * vt + 8 * g + 4 * hi; const u32x2 om = *(const u32x2*)(omp + v0); const f32x4 gg = *(const f32x4*)(ng + v0);
            const float y0 = (o[vt][4 * g] - mu) * rstd * gg[0] * sigmoidf_(bflo(om.x)), y1 = (o[vt][4 * g + 1] - mu) * rstd * gg[1] * sigmoidf_(bfhi(om.x));
            const float y2 = (o[vt][4 * g + 2] - mu) * rstd * gg[2] * sigmoidf_(bflo(om.y)), y3 = (o[vt][4 * g + 3] - mu) * rstd * gg[3] * sigmoidf_(bfhi(om.y));
            u32x2 wv; wv.x = cvt_pk_bf16(y0, y1); wv.y = cvt_pk_bf16(y2, y3); *(u32x2*)(yp + v0) = wv; }
    __syncthreads();
}

namespace at64 {
constexpr int D = 64, PD = NPJ, OD = 1024, NW = 8, QBLK = 32, QB = QBLK * NW, KVBLK = 64;
constexpr float C2 = 0.125f * 1.4426950408889634f;
constexpr int SLOTB = 8192, LDS_K = 0, LDS_V = 3 * SLOTB, LDS_WS = 6 * SLOTB, LDS_OST = LDS_WS + NW * 256, LDS_BODY = LDS_OST + NW * 4096;
constexpr int LDS_BT = 86016;
constexpr int ATHR = 8;
#define SBAR() __builtin_amdgcn_sched_barrier(0)
#define PIN(x) asm volatile("" : "+v"(x))
#define MFMA(a, b, c) __builtin_amdgcn_mfma_f32_32x32x16_bf16(a, b, c, 0, 0, 0)
#define WAIT_BAR(N) asm volatile("s_waitcnt vmcnt(" #N ") lgkmcnt(0)\n\ts_barrier" ::: "memory")
__device__ __forceinline__ unsigned cvtpk(float lo, float hi) { unsigned r; asm("v_cvt_pk_bf16_f32 %0, %1, %2" : "=v"(r) : "v"(lo), "v"(hi)); return r; }
__device__ __forceinline__ void glds16(const void* g, unsigned lds_base) {
    unsigned sv; asm volatile("s_mov_b32 %0, m0\n\ts_mov_b32 m0, %2\n\ts_nop 0\n\tglobal_load_lds_dwordx4 %1, off\n\ts_mov_b32 m0, %0" : "=&s"(sv) : "v"(g), "s"(lds_base) : "memory"); }
typedef __attribute__((address_space(3))) const char* lds_cptr;
typedef short v4i16_t __attribute__((ext_vector_type(4)));
__device__ __forceinline__ void kload2(bf16x8* kf, lds_cptr kp, int d0) { kf[2 * d0] = *(const __attribute__((address_space(3))) bf16x8*)(kp + d0 * 2048); kf[2 * d0 + 1] = *(const __attribute__((address_space(3))) bf16x8*)(kp + d0 * 2048 + 512); }
__device__ __forceinline__ s16x4 vtr(lds_cptr p) { return __builtin_bit_cast(s16x4, __builtin_amdgcn_ds_read_tr16_b64_v4i16((__attribute__((address_space(3))) v4i16_t*)p)); }
#define MX3(a, b, c) __builtin_fmaxf(__builtin_fmaxf((a), (b)), (c))
__device__ __forceinline__ float rowmax(const f32x16& p0, const f32x16& p1) {
    float a = MX3(p0[0], p0[1], p1[0]), b = MX3(p0[2], p0[3], p1[1]); a = MX3(a, p1[2], p1[3]);
#pragma unroll
    for (int r = 4; r < 16; r += 4) { a = MX3(a, p0[r], p0[r + 1]); b = MX3(b, p0[r + 2], p0[r + 3]); a = MX3(a, p1[r], p1[r + 1]); b = MX3(b, p1[r + 2], p1[r + 3]); }
    float m = __builtin_fmaxf(a, b); auto rr = __builtin_amdgcn_permlane32_swap(__float_as_uint(m), __float_as_uint(m), false, false);
    return __builtin_fmaxf(__uint_as_float(rr[0]), __uint_as_float(rr[1])); }
__device__ __forceinline__ void maskinit(f32x16& p0, f32x16& p1, unsigned long long mw, int hi) {
    const unsigned lo = (unsigned)mw >> (4 * hi), hh = (unsigned)(mw >> 32) >> (4 * hi);
#pragma unroll
    for (int r = 0; r < 16; ++r) { const int pos = (r & 3) + 8 * (r >> 2);
        p0[r] = __uint_as_float((unsigned)((int)(lo << (31 - pos)) >> 31) & 0xff800000u); p1[r] = __uint_as_float((unsigned)((int)(hh << (31 - pos)) >> 31) & 0xff800000u); } }
__device__ __forceinline__ void bandfix(f32x16& p0, f32x16& p1, int jb, int qrel, int hi, const LAS float* bt) {
    int kb = qrel - 64 * jb - 4 * hi; SBAR(); PIN(kb);
#pragma unroll
    for (int r = 0; r < 16; ++r) { const int d0 = kb - ((r & 3) + 8 * (r >> 2)), d1 = d0 - 32;
        p0[r] += bt[d0 < 0 ? 0 : (d0 > 127 ? 127 : d0)]; p1[r] += bt[d1 < 0 ? 0 : (d1 > 127 ? 127 : d1)];
        if ((r & 3) == 3) { PIN(p0); PIN(p1); PIN(kb); SBAR(); } } }

__device__ __forceinline__ void attn64_unit(int b, int h, int qb, const bf16_t* Q, const bf16_t* __restrict__ K, const bf16_t* __restrict__ V, bf16_t* O, const unsigned long long* MW, char* lds, const LAS float* bt_all) {
    const int tid = threadIdx.x, lane = tid & 63, r32 = lane & 31, hi = lane >> 5; const int wid = __builtin_amdgcn_readfirstlane(tid >> 6);
    const long rowbase = (long)b * SEQ; const int q0 = qb * QB, NT = (q0 + QB) / KVBLK;
    const bf16_t* Qw = Q + (rowbase + q0 + wid * QBLK) * PD + h * D;
    const unsigned lds0 = (unsigned)(uintptr_t)lds; float* wsf = (float*)(lds + LDS_WS) + wid * 64;
    const LAS float* bt = bt_all + h * 128;
    const unsigned long long* mwp = MW + ((size_t)(b * 128 + qb * 8 + wid) * 64) * 32 + r32;
    const bf16_t* ksrc = K + rowbase * PD + h * D + (long)lane * PD + wid * 8;
    const bf16_t* vsrc = V + rowbase * PD + h * D + (long)(16 * (wid & 3) + (lane >> 2)) * PD + (wid >> 2) * 32 + (lane & 3) * 8;
    const unsigned kdst = lds0 + LDS_K + wid * 1024, vdst = lds0 + LDS_V + wid * 1024;
#define DMA_K(t, slot) glds16(ksrc + (long)(t) * KVBLK * PD, (unsigned)__builtin_amdgcn_readfirstlane(kdst + (slot)))
#define DMA_V(t, slot) glds16(vsrc + (long)(t) * KVBLK * PD, (unsigned)__builtin_amdgcn_readfirstlane(vdst + (slot)))
    const lds_cptr vp0 = (lds_cptr)lds + LDS_V + ((lane >> 4) & 1) * 32 + (lane & 3) * 8 + (4 * hi + ((lane & 15) >> 2)) * 64;
    const lds_cptr kp0 = (lds_cptr)lds + LDS_K + hi * 1024 + r32 * 16;
    DMA_K(0, 0); DMA_V(0, 0); DMA_K(1, SLOTB);
    bf16x8 qr[4];
#pragma unroll
    for (int d0 = 0; d0 < 4; ++d0) qr[d0] = *reinterpret_cast<const bf16x8*>(&Qw[(long)r32 * PD + d0 * 16 + hi * 8]);
    unsigned long long mwc = mwp[0], mwn = mwp[32];
    float mhat = 0.f, l_reg = 0.f; f32x16 o[2]; o[0] = f32x16{}; o[1] = f32x16{};
    const int qrel = wid * QBLK + r32; bool resc = false;
    f32x16 pA0, pA1, pB0, pB1; bf16x8 kf[8]; s16x4 vlo[8], vhi[8]; u32x4 pw0, pw1, pw2, pw3;
    int sl_prev = 0, sl_cur = 0, sl_next = SLOTB;
#define ROT() do { sl_prev = sl_cur; sl_cur = sl_next; sl_next = (sl_next == 2 * SLOTB) ? 0 : sl_next + SLOTB; } while (0)
#define EX(v) __builtin_amdgcn_exp2f(__builtin_fmaf((v), C2, nmh))
#define RESC() do { if (resc) { _Pragma("unroll") for (int d_ = 0; d_ < 2; ++d_) _Pragma("unroll") for (int r = 0; r < 16; ++r) o[d_][r] *= wsf[crow(r, hi)]; } } while (0)
    DMA_K(2, 2 * SLOTB);
    WAIT_BAR(3);
    _Pragma("unroll") for (int d0 = 0; d0 < 4; ++d0) kload2(kf, kp0, d0);
    maskinit(pA0, pA1, mwc, hi); mwc = mwn;
    pA0 = MFMA(kf[0], qr[0], pA0); pA1 = MFMA(kf[1], qr[0], pA1); pA0 = MFMA(kf[2], qr[1], pA0); pA1 = MFMA(kf[3], qr[1], pA1);
    pA0 = MFMA(kf[4], qr[2], pA0); pA1 = MFMA(kf[5], qr[2], pA1); pA0 = MFMA(kf[6], qr[3], pA0); pA1 = MFMA(kf[7], qr[3], pA1);
    if (NT == 4) bandfix(pA0, pA1, 0, qrel, hi, bt);
    { const float rm = rowmax(pA0, pA1); mhat = __builtin_fmaxf(rm * C2, -1.0e4f); const float nmh = -mhat;
#pragma unroll
      for (int r = 0; r < 16; ++r) { pA0[r] = EX(pA0[r]); pA1[r] = EX(pA1[r]); } }
    WAIT_BAR(0);
    DMA_K(3, 0); DMA_V(1, SLOTB); ROT();
    _Pragma("unroll") for (int d0 = 0; d0 < 4; ++d0) kload2(kf, kp0 + sl_cur, d0);
    WAIT_BAR(2);
#define PKW(P, i) cvtpk(P[i], P[i + 1])
#define PAF(k) __builtin_bit_cast(bf16x8, pw##k)
#define VFR(i) (bf16x8){vlo[i][0], vlo[i][1], vlo[i][2], vlo[i][3], vhi[i][0], vhi[i][1], vhi[i][2], vhi[i][3]}
#define VRD(i) do { vlo[i] = vtr(vp_ + (((i) >> 2) * 4096 + ((i) & 3) * 1024)); vhi[i] = vtr(vp_ + (((i) >> 2) * 4096 + ((i) & 3) * 1024 + 512)); } while (0)
#define KRD(G, d0) do { if (G) { kload2(kf, kp0 + sl_next, d0); SBAR(); } } while (0)
#define GAPA(MF, a0, a1, a2, a3, W0, W1, PW) do { MF; sacc += a0; sacc += a1; sacc += a2; sacc += a3; W0; W1; PIN(PW); PIN(sacc); SBAR(); } while (0)
#define GAPB(MF, X, i) do { MF; X[i] = EX(X[i]); X[i + 1] = EX(X[i + 1]); X[i + 2] = EX(X[i + 2]); X[i + 3] = EX(X[i + 3]); PIN(X); SBAR(); } while (0)
#define STEP(C0, C1, P0, P1, t, MASK, GK, GV, GL) do { SBAR(); \
    const lds_cptr vp_ = vp0 + sl_prev; maskinit(C0, C1, mwc, hi); mwc = mwp[(size_t)(((t) + 1) > 63 ? 63 : ((t) + 1)) * 32]; SBAR(); \
    VRD(0); SBAR(); float sacc = P0[0] + P0[1]; \
                    GAPA(C0 = MFMA(kf[0], qr[0], C0),     P0[2], P0[3], P0[4], P0[5],     pw0[0] = PKW(P0, 0),  pw0[1] = PKW(P0, 2),  pw0); \
    VRD(4); SBAR(); GAPA(C1 = MFMA(kf[1], qr[0], C1),     P0[6], P0[7], P0[8], P0[9],     pw0[2] = PKW(P0, 4),  pw0[3] = PKW(P0, 6),  pw0); \
    VRD(1); SBAR(); GAPA(C0 = MFMA(kf[2], qr[1], C0),    P0[10], P0[11], P0[12], P0[13], pw1[0] = PKW(P0, 8),  pw1[1] = PKW(P0, 10), pw1); \
    VRD(5); SBAR(); GAPA(C1 = MFMA(kf[3], qr[1], C1),    P0[14], P0[15], P1[0], P1[1],   pw1[2] = PKW(P0, 12), pw1[3] = PKW(P0, 14), pw1); \
    VRD(2); SBAR(); GAPA(C0 = MFMA(kf[4], qr[2], C0),    P1[2], P1[3], P1[4], P1[5],     pw2[0] = PKW(P1, 0),  pw2[1] = PKW(P1, 2),  pw2); \
    VRD(6); SBAR(); GAPA(C1 = MFMA(kf[5], qr[2], C1),    P1[6], P1[7], P1[8], P1[9],     pw2[2] = PKW(P1, 4),  pw2[3] = PKW(P1, 6),  pw2); \
    VRD(3); SBAR(); GAPA(C0 = MFMA(kf[6], qr[3], C0),    P1[10], P1[11], P1[12], P1[13], pw3[0] = PKW(P1, 8),  pw3[1] = PKW(P1, 10), pw3); \
    VRD(7); SBAR(); GAPA(C1 = MFMA(kf[7], qr[3], C1),    P1[14], P1[15], 0.f, 0.f,       pw3[2] = PKW(P1, 12), pw3[3] = PKW(P1, 14), pw3); \
    l_reg += sacc; \
    if (GK) DMA_K((t) + 3, sl_cur); if (GV) DMA_V((t) + 1, sl_next); \
    if (MASK) bandfix(C0, C1, (t) - (NT - 4), qrel, hi, bt); \
    { const float rm = __builtin_fmaf(rowmax(C0, C1), C2, -mhat); resc = false; \
      if (__builtin_expect(__any(rm > (float)ATHR), 0)) { const float dl = __builtin_fmaxf(rm, 0.f); mhat += dl; \
          const float f = __builtin_amdgcn_exp2f(-dl); l_reg *= f; if (hi == 0) wsf[r32] = f; resc = true; } } \
    const float nmh = -mhat; SBAR(); \
    GAPB(o[0] = MFMA(PAF(0), VFR(0), o[0]), C0, 0);              GAPB(o[1] = MFMA(PAF(0), VFR(4), o[1]), C0, 4); \
    KRD(GL, 0); GAPB(o[0] = MFMA(PAF(1), VFR(1), o[0]), C0, 8);  KRD(GL, 1); GAPB(o[1] = MFMA(PAF(1), VFR(5), o[1]), C0, 12); \
    KRD(GL, 2); GAPB(o[0] = MFMA(PAF(2), VFR(2), o[0]), C1, 0);  KRD(GL, 3); GAPB(o[1] = MFMA(PAF(2), VFR(6), o[1]), C1, 4); \
    GAPB(o[0] = MFMA(PAF(3), VFR(3), o[0]), C1, 8);              GAPB(o[1] = MFMA(PAF(3), VFR(7), o[1]), C1, 12); \
    } while (0)
    int t = 1;
    for (; t + 7 < NT; t += 2) {
        STEP(pB0, pB1, pA0, pA1, t, false, true, true, true);     WAIT_BAR(2); RESC(); ROT();
        STEP(pA0, pA1, pB0, pB1, t + 1, false, true, true, true); WAIT_BAR(2); RESC(); ROT();
    }
#define ENDW(tt) do { if ((tt) + 3 < NT) { WAIT_BAR(2); } else if ((tt) + 2 < NT) { WAIT_BAR(1); } else { WAIT_BAR(0); } } while (0)
    for (; t + 1 < NT; t += 2) {
        STEP(pB0, pB1, pA0, pA1, t, true, (t + 3 < NT), (t + 1 < NT), (t + 1 < NT));         ENDW(t);     RESC(); ROT();
        STEP(pA0, pA1, pB0, pB1, t + 1, true, (t + 4 < NT), (t + 2 < NT), (t + 2 < NT));     ENDW(t + 1); RESC(); ROT();
    }
    STEP(pB0, pB1, pA0, pA1, NT - 1, true, false, false, false); RESC();
    { float sacc = pB0[0] + pB0[1];
#pragma unroll
      for (int r = 2; r < 16; ++r) sacc += pB0[r];
#pragma unroll
      for (int r = 0; r < 16; ++r) sacc += pB1[r];
      l_reg += sacc;
      pw0 = (u32x4){PKW(pB0, 0), PKW(pB0, 2), PKW(pB0, 4), PKW(pB0, 6)}; pw1 = (u32x4){PKW(pB0, 8), PKW(pB0, 10), PKW(pB0, 12), PKW(pB0, 14)};
      pw2 = (u32x4){PKW(pB1, 0), PKW(pB1, 2), PKW(pB1, 4), PKW(pB1, 6)}; pw3 = (u32x4){PKW(pB1, 8), PKW(pB1, 10), PKW(pB1, 12), PKW(pB1, 14)};
      const lds_cptr vp_ = vp0 + sl_cur; _Pragma("unroll") for (int i = 0; i < 8; ++i) VRD(i);
      o[0] = MFMA(PAF(0), VFR(0), o[0]); o[1] = MFMA(PAF(0), VFR(4), o[1]); o[0] = MFMA(PAF(1), VFR(1), o[0]); o[1] = MFMA(PAF(1), VFR(5), o[1]);
      o[0] = MFMA(PAF(2), VFR(2), o[0]); o[1] = MFMA(PAF(2), VFR(6), o[1]); o[0] = MFMA(PAF(3), VFR(3), o[0]); o[1] = MFMA(PAF(3), VFR(7), o[1]); }
    { auto rr = __builtin_amdgcn_permlane32_swap(__float_as_uint(l_reg), __float_as_uint(l_reg), false, false); l_reg = __uint_as_float(rr[0]) + __uint_as_float(rr[1]); }
    if (hi == 0) wsf[32 + r32] = l_reg; asm volatile("s_waitcnt lgkmcnt(0)" ::: "memory");
    float rli[16];
#pragma unroll
    for (int r = 0; r < 16; ++r) rli[r] = __builtin_amdgcn_rcpf(wsf[32 + crow(r, hi)]);
    bf16_t* Ow = O + (rowbase + q0 + wid * QBLK) * OD + h * D; bf16_t* stg = (bf16_t*)(lds + LDS_OST) + wid * 2048;
#pragma unroll
    for (int r = 0; r < 16; ++r) { const int orow = crow(r, hi);
#pragma unroll
        for (int d0 = 0; d0 < 2; ++d0) stg[orow * 64 + d0 * 32 + r32] = f2bf(o[d0][r] * rli[r]); }
    asm volatile("s_waitcnt lgkmcnt(0)" ::: "memory");
#pragma unroll
    for (int i = 0; i < 4; ++i) { const int row = i * 8 + (lane >> 3), ch = lane & 7; *(u32x4*)(Ow + (long)row * OD + ch * 8) = *(const u32x4*)(stg + row * 64 + ch * 8); }
    asm volatile("s_waitcnt lgkmcnt(0)\n\ts_barrier" ::: "memory");
#undef DMA_K
#undef DMA_V
#undef ROT
#undef EX
#undef RESC
#undef PKW
#undef PAF
#undef VFR
#undef VRD
#undef KRD
#undef ENDW
#undef GAPA
#undef GAPB
#undef STEP
}
}

__device__ __forceinline__ float reduce32(float (&v)[32], int lane) {
#pragma unroll
    for (int off = 32, n = 16; n >= 1; off >>= 1, n >>= 1) {
        const bool up = (lane & off) != 0;
#pragma unroll
        for (int i = 0; i < n; ++i) { const float keep = up ? v[i + n] : v[i], send = up ? v[i] : v[i + n]; v[i] = keep + __shfl_xor(send, off); }
    }
    return v[0] + __shfl_xor(v[0], 1);
}
__device__ __forceinline__ void p7_ln_router(Frame& F) {
    float* z = (float*)(F.ws + WS_R1); bf16_t* x1b = (bf16_t*)(F.ws + WS_XB);
    int* tokl = (int*)(F.ws + WS_TOK); float* gatel = (float*)(F.ws + WS_GATE); int* pairl = (int*)(F.ws + WS_PAIR); unsigned* cnt = (unsigned*)(F.ws + WS_CTL) + CW_CNT;
    LAS float* WR = (LAS float*)F.lds;
    LAS int* PB = (LAS int*)(F.lds + 131072);
    LAS int* HIST = (LAS int*)(F.lds + 131072 + 16384);
    const int tid = F.tid, lane = F.lane, w = F.wave;
    for (int i = tid; i < 32 * 1024; i += 512) { const int k = i >> 5, e = i & 31; WR[e * 1024 + k] = F.w_router[i]; }
    if (tid < 64) HIST[tid] = 0;
    __syncthreads();
    const int per = (T + F.G - 1) / F.G; const int t0 = F.bid * per, t1 = (t0 + per < T) ? t0 + per : T;
    int npair = 0;
    for (int t = t0 + w; t < t1; t += 8) {
        f32x4* zr = (f32x4*)(z + (size_t)t * 1024) + lane; f32x4 v[4]; float s = 0.f;
#pragma unroll
        for (int j = 0; j < 4; ++j) { v[j] = zr[64 * j]; s += (v[j][0] + v[j][1]) + (v[j][2] + v[j][3]); }
        const float mean = wave_sum(s) * (1.f / 1024.f); float s2 = 0.f;
#pragma unroll
        for (int j = 0; j < 4; ++j) { v[j] = v[j] - mean; s2 += (v[j][0] * v[j][0] + v[j][1] * v[j][1]) + (v[j][2] * v[j][2] + v[j][3] * v[j][3]); }
        const float rstd = 1.f / sqrtf(wave_sum(s2) * (1.f / 1024.f) + LN_EPS);
        u32x2* xb = (u32x2*)(x1b + (size_t)t * 1024) + lane;
#pragma unroll
        for (int j = 0; j < 4; ++j) { const f32x4 g = *((const f32x4*)F.ln1_g + 64 * j + lane), bb = *((const f32x4*)F.ln1_b + 64 * j + lane);
            v[j] = v[j] * rstd * g + bb; zr[64 * j] = v[j]; u32x2 pk; pk.x = cvt_pk_bf16(v[j][0], v[j][1]); pk.y = cvt_pk_bf16(v[j][2], v[j][3]); xb[64 * j] = pk; }
        float lg[32];
#pragma unroll
        for (int e = 0; e < 32; ++e) { float a = 0.f;
#pragma unroll
            for (int j = 0; j < 4; ++j) { const f32x4 wv = *((const LAS f32x4*)(WR + e * 1024) + 64 * j + lane); a += (v[j][0] * wv[0] + v[j][1] * wv[1]) + (v[j][2] * wv[2] + v[j][3] * wv[3]); }
            lg[e] = a; }
        float logit = reduce32(lg, lane); const int myE = (lane >> 1) & 31; logit += F.b_router[myE];
        float tv[4]; int te[4]; float cur = logit;
#pragma unroll
        for (int k = 0; k < 4; ++k) { float bv = cur; int be = myE;
#pragma unroll
            for (int o = 2; o < 64; o <<= 1) { const float ov = __shfl_xor(bv, o); const int oe = __shfl_xor(be, o); if (ov > bv || (ov == bv && oe < be)) { bv = ov; be = oe; } }
            tv[k] = bv; te[k] = be; if (myE == be) cur = -INFINITY; }
        const float e1 = __expf(tv[1] - tv[0]), e2 = __expf(tv[2] - tv[0]), e3 = __expf(tv[3] - tv[0]); const float inv = 1.f / (1.f + e1 + e2 + e3);
        if (lane < 4) { const float gk = (lane == 0 ? 1.f : lane == 1 ? e1 : lane == 2 ? e2 : e3) * inv; const int ek = (lane == 0 ? te[0] : lane == 1 ? te[1] : lane == 2 ? te[2] : te[3]);
            const int li = atomicAdd((int*)&HIST[ek], 1); const int pi = ((t - t0) * 4 + lane);
            PB[pi * 4 + 0] = t; PB[pi * 4 + 1] = ek; PB[pi * 4 + 2] = __float_as_int(gk); PB[pi * 4 + 3] = li; }
    }
    npair = (t1 - t0) * 4;
    __syncthreads();
    if (tid < 32) HIST[32 + tid] = (int)atomicAdd(&cnt[tid], (unsigned)HIST[tid]);
    __syncthreads();
    for (int p = tid; p < npair; p += 512) { const int t = PB[p * 4], e = PB[p * 4 + 1], slot = HIST[32 + e] + PB[p * 4 + 3];
        tokl[e * ECAP + slot] = t; gatel[e * ECAP + slot] = __int_as_float(PB[p * 4 + 2]); pairl[t * 4 + (p & 3)] = (e << 16) | slot; }
    __syncthreads();
}
__device__ __forceinline__ void moe_tables(Frame& F, LAS int* tstart, LAS int* cntl) {
    const unsigned* cnt = (const unsigned*)(F.ws + WS_CTL) + CW_CNT;
    if (F.tid < 32) cntl[F.tid] = (int)__hip_atomic_load(cnt + F.tid, __ATOMIC_RELAXED, __HIP_MEMORY_SCOPE_AGENT);
    __syncthreads();
    if (F.tid == 0) { int a = 0; for (int e = 0; e < 32; ++e) { tstart[e] = a; a += (cntl[e] + 255) >> 8; } tstart[32] = a; }
    __syncthreads();
}
__device__ __forceinline__ void p11_combine(Frame& F, const LAS int* tstart) {
    const float* x1 = (const float*)(F.ws + WS_R1); const bf16_t* y2 = (const bf16_t*)(F.ws + WS_Y2); const int* pairl = (const int*)(F.ws + WS_PAIR);
    const int lane = F.lane; const int gw = F.bid * 8 + F.wave, NGW = F.G * 8;
    for (int t = gw; t < T; t += NGW) {
        const f32x4* xr = (const f32x4*)(x1 + (size_t)t * 1024) + lane; f32x4 v[4];
#pragma unroll
        for (int j = 0; j < 4; ++j) v[j] = xr[64 * j] * DN_ALPHA;
#pragma unroll
        for (int k = 0; k < 4; ++k) { const int pr = pairl[t * 4 + k]; const int e = pr >> 16, slot = pr & 0xffff; const size_t row = (size_t)tstart[e] * 256 + slot;
            const u32x2* yr = (const u32x2*)(y2 + row * 1024) + lane;
#pragma unroll
            for (int j = 0; j < 4; ++j) { const u32x2 q = yr[64 * j]; v[j][0] += bflo(q.x); v[j][1] += bfhi(q.x); v[j][2] += bflo(q.y); v[j][3] += bfhi(q.y); } }
        float s = 0.f;
#pragma unroll
        for (int j = 0; j < 4; ++j) s += (v[j][0] + v[j][1]) + (v[j][2] + v[j][3]);
        const float mean = wave_sum(s) * (1.f / 1024.f); float s2 = 0.f;
#pragma unroll
        for (int j = 0; j < 4; ++j) { v[j] = v[j] - mean; s2 += (v[j][0] * v[j][0] + v[j][1] * v[j][1]) + (v[j][2] * v[j][2] + v[j][3] * v[j][3]); }
        const float rstd = 1.f / sqrtf(wave_sum(s2) * (1.f / 1024.f) + LN_EPS);
        f32x4* orow = (f32x4*)(F.out + (size_t)t * 1024) + lane;
#pragma unroll
        for (int j = 0; j < 4; ++j) { const f32x4 g = *((const f32x4*)F.ln2_g + 64 * j + lane), bb = *((const f32x4*)F.ln2_b + 64 * j + lane); orow[64 * j] = v[j] * rstd * g + bb; }
    }
}

struct Args { const float* in[21]; float* out; unsigned char* ws; int ph_lo, ph_hi; };
__device__ __forceinline__ void frame_init(Frame& F, const Args& args, unsigned char* lds_dyn) {
    F.lds = (LAS unsigned char*)lds_dyn; F.ws = args.ws;
    F.tid = threadIdx.x; F.lane = F.tid & 63; F.wave = __builtin_amdgcn_readfirstlane(F.tid >> 6); F.G = gridDim.x; F.bid = blockIdx.x;
    F.x = args.in[0]; F.w_in = args.in[1]; F.conv_w = args.in[2]; F.conv_b = args.in[3]; F.i_bias = args.in[4]; F.f_bias = args.in[5]; F.norm_g = args.in[6];
    F.w_ba = args.in[7]; F.w_bm = args.in[8]; F.w_out = args.in[9]; F.ln1_g = args.in[10]; F.ln1_b = args.in[11]; F.w_router = args.in[12]; F.b_router = args.in[13];
    F.w_gu = args.in[14]; F.b_gu = args.in[15]; F.w_down = args.in[16]; F.b_down = args.in[17]; F.ln2_g = args.in[18]; F.ln2_b = args.in[19]; F.rel_bias = args.in[20];
    F.out = args.out;
}
template <int PH>
__device__ __forceinline__ void phase_body(Frame& F, unsigned char* lds_dyn) {
    LAS int* TST = (LAS int*)(F.lds + LDS_MISC + 256); LAS int* CNTL = TST + 40;
    if constexpr (PH == 0) { p0_prologue(F); }
    if constexpr (PH == 1) {
        pg8::DenseOrder S{(const char*)(F.ws + WS_XB), (const char*)(F.ws + WS_WIN), 1024, 1024, T / 256, NWIN / 256, F.G, F.bid};
        EpiProj E{(bf16_t*)(F.ws + WS_PROJ), (bf16_t*)(F.ws + WS_KI), (float*)(F.ws + WS_SMALL)};
        pg8::gemm_phase<EpiProj, pg8::DenseOrder>(F.lds, 1024, S, E);
    }
    if constexpr (PH == 2) {
        for (int u = F.bid; u < 256; u += F.G) { const int b = u & 7, j = u >> 3;
#pragma unroll 1
            for (int q = 0; q < 4; ++q) { const int qb = (q == 0) ? j : (q == 1) ? 63 - j : (q == 2) ? 64 + j : 127 - j; idx_unit(F, b, qb); } }
#pragma unroll 1
        for (int u = F.bid; u < 512; u += F.G) mlstm_local_unit(F, u >> 6, u & 63);
    }
    if constexpr (PH == 3) {
        mlstm_scan(F);
        LAS float* BT = (LAS float*)(F.lds + at64::LDS_BT);
        for (int i = F.tid; i < 8 * 128; i += 512) { const int h = i >> 7, n = i & 127; int bk;
            if (n < 16) bk = n; else { bk = 16 + (int)(logf((float)n / 16.0f) / 2.0794415416798357f * 16.0f); bk = bk > 31 ? 31 : bk; }
            BT[i] = (F.rel_bias[h * 32 + bk] - F.rel_bias[h * 32 + 31]) * 8.0f; }
        __syncthreads();
        const bf16_t* proj = (const bf16_t*)(F.ws + WS_PROJ);
#pragma unroll 1
        for (int p2 = F.bid * 2; p2 < 1024; p2 += F.G * 2) {
#pragma unroll 1
            for (int q = 0; q < 2; ++q) { const int p = p2 >> 1; const int x = p & 7, kk = p >> 3, bh = x + 8 * (kk >> 3), j = kk & 7; const int qb = q ? 15 - j : j;
                at64::attn64_unit(bh >> 3, bh & 7, qb, proj + C_QA, proj + C_KA, proj + C_VA, (bf16_t*)(F.ws + WS_YCAT), (const unsigned long long*)(F.ws + WS_MW), (char*)lds_dyn, BT); } }
    }
    if constexpr (PH == 4) {
#pragma unroll 1
        for (int u = F.bid; u < 512; u += F.G) mlstm_out_unit(F, u >> 6, u & 63); }
    if constexpr (PH == 5) {
        pg8::MergeOrder S{(const char*)(F.ws + WS_YCAT), (const char*)(F.ws + WS_WCAT), F.G, F.bid};
        EpiMerge E{(const bf16_t*)(F.ws + WS_PROJ), (bf16_t*)(F.ws + WS_MIX)};
        pg8::gemm_phase<EpiMerge, pg8::MergeOrder>(F.lds, 512, S, E);
    }
    if constexpr (PH == 6) {
        pg8::DenseOrder S{(const char*)(F.ws + WS_MIX), (const char*)(F.ws + WS_WO), 1024, 1024, T / 256, 4, F.G, F.bid};
        EpiOut E{F.x, (float*)(F.ws + WS_R1)};
        pg8::gemm_phase<EpiOut, pg8::DenseOrder>(F.lds, 1024, S, E);
    }
    if constexpr (PH == 7) { p7_ln_router(F); }
    if constexpr (PH == 9) {
        moe_tables(F, TST, CNTL);
        pg8::MoeOrder S{TST, CNTL, (const char*)(F.ws + WS_XB), (const char*)(F.ws + WS_WGU), (const int*)(F.ws + WS_TOK), 8, F.G, F.bid, (size_t)2048 * 1024 * 2, true};
        EpiGateUp E{F.b_gu, (bf16_t*)(F.ws + WS_PROJ)};
        pg8::gemm_phase<EpiGateUp, pg8::MoeOrder>(F.lds, 1024, S, E);
    }
    if constexpr (PH == 10) {
        moe_tables(F, TST, CNTL);
        pg8::MoeOrder S{TST, CNTL, (const char*)(F.ws + WS_PROJ), (const char*)(F.ws + WS_WD), (const int*)(F.ws + WS_TOK), 4, F.G, F.bid, (size_t)1024 * 1024 * 2, false};
        EpiDown E{F.b_down, (const float*)(F.ws + WS_GATE), (bf16_t*)(F.ws + WS_Y2)};
        pg8::gemm_phase<EpiDown, pg8::MoeOrder>(F.lds, 1024, S, E);
    }
    if constexpr (PH == 11) { moe_tables(F, TST, CNTL); p11_combine(F, TST); }
}
#if MK_PER_PHASE
template <int PH>
__global__ void __launch_bounds__(512, 2) mk_phase(Args args) {
    extern __shared__ __attribute__((aligned(16))) unsigned char lds_dyn[];
    Frame F; frame_init(F, args, lds_dyn);
    phase_body<PH>(F, lds_dyn);
}
#else
__global__ void __launch_bounds__(512, 2) mk_fwd(Args args) {
    extern __shared__ __attribute__((aligned(16))) unsigned char lds_dyn[];
    Frame F; frame_init(F, args, lds_dyn);
    volatile LAS unsigned* MISC = (volatile LAS unsigned*)(F.lds + LDS_MISC);
    if (F.tid < 64) MISC[F.tid] = 0u;
    __syncthreads();
    XcdBarrier bar = xcd_barrier_post((unsigned*)(F.ws + WS_CTL) + CW_BAR, MISC + 8);
    phase_body<0>(F, lds_dyn); xcd_barrier(bar);
    phase_body<1>(F, lds_dyn); xcd_barrier(bar);
    phase_body<2>(F, lds_dyn); xcd_barrier(bar);
    phase_body<3>(F, lds_dyn); xcd_barrier(bar);
    phase_body<4>(F, lds_dyn); xcd_barrier(bar);
    phase_body<5>(F, lds_dyn); xcd_barrier(bar);
    phase_body<6>(F, lds_dyn); xcd_barrier(bar);
    phase_body<7>(F, lds_dyn); xcd_barrier(bar);
    phase_body<9>(F, lds_dyn); xcd_barrier(bar);
    phase_body<10>(F, lds_dyn); xcd_barrier(bar);
    phase_body<11>(F, lds_dyn);
}
#endif

template <class KF> static bool setup_kernel(KF kf) {
    if (hipFuncSetAttribute((const void*)kf, hipFuncAttributeMaxDynamicSharedMemorySize, LDS_BYTES) != hipSuccess) { fprintf(stderr, "kernel_launch: hipFuncSetAttribute failed\n"); return false; }
    return true;
}
extern "C" void kernel_launch(void* const* d_in, const int* in_sizes, int n_in, void* d_out, int out_size, void* d_ws, size_t ws_size, hipStream_t stream) {
    static int grid = 0;
    if (grid == 0) {
        if (n_in != 21 || ws_size < WS_END) { fprintf(stderr, "kernel_launch: unexpected n_in %d / ws %zu\n", n_in, ws_size); grid = -1; return; }
        int dev = 0, cus = 0;
        (void)hipGetDevice(&dev); (void)hipDeviceGetAttribute(&cus, hipDeviceAttributeMultiprocessorCount, dev);
        bool ok = true;
#if MK_PER_PHASE
        ok = ok && setup_kernel(mk_phase<0>) && setup_kernel(mk_phase<1>) && setup_kernel(mk_phase<2>) && setup_kernel(mk_phase<3>) && setup_kernel(mk_phase<4>) && setup_kernel(mk_phase<5>)
                && setup_kernel(mk_phase<6>) && setup_kernel(mk_phase<7>) && setup_kernel(mk_phase<9>) && setup_kernel(mk_phase<10>) && setup_kernel(mk_phase<11>);
#else
        ok = ok && setup_kernel(mk_fwd);
        int per_cu = 0;
        if (hipOccupancyMaxActiveBlocksPerMultiprocessor(&per_cu, (const void*)mk_fwd, 512, LDS_BYTES) != hipSuccess || per_cu < 1) { fprintf(stderr, "kernel_launch: occupancy query says %d\n", per_cu); }
#endif
        (void)hipGetLastError();
        if (!ok) { grid = -1; return; }
        grid = cus > 0 ? cus : 256;
        if (grid > 256) grid = 256;
    }
    if (grid < 0) return;
    (void)hipMemsetAsync((char*)d_ws + WS_CTL, 0, CTL_BYTES, stream);
    Args a{};
    for (int i = 0; i < 21; ++i) a.in[i] = (const float*)d_in[i];
    a.out = (float*)d_out; a.ws = (unsigned char*)d_ws; a.ph_lo = 0; a.ph_hi = NPHASE;
#if MK_PER_PHASE
    hipLaunchKernelGGL(mk_phase<0>, dim3(grid), dim3(512), LDS_BYTES, stream, a);
    hipLaunchKernelGGL(mk_phase<1>, dim3(grid), dim3(512), LDS_BYTES, stream, a);
    hipLaunchKernelGGL(mk_phase<2>, dim3(grid), dim3(512), LDS_BYTES, stream, a);
    hipLaunchKernelGGL(mk_phase<3>, dim3(grid), dim3(512), LDS_BYTES, stream, a);
    hipLaunchKernelGGL(mk_phase<4>, dim3(grid), dim3(512), LDS_BYTES, stream, a);
    hipLaunchKernelGGL(mk_phase<5>, dim3(grid), dim3(512), LDS_BYTES, stream, a);
    hipLaunchKernelGGL(mk_phase<6>, dim3(grid), dim3(512), LDS_BYTES, stream, a);
    hipLaunchKernelGGL(mk_phase<7>, dim3(grid), dim3(512), LDS_BYTES, stream, a);
    hipLaunchKernelGGL(mk_phase<9>, dim3(grid), dim3(512), LDS_BYTES, stream, a);
    hipLaunchKernelGGL(mk_phase<10>, dim3(grid), dim3(512), LDS_BYTES, stream, a);
    hipLaunchKernelGGL(mk_phase<11>, dim3(grid), dim3(512), LDS_BYTES, stream, a);
#else
    hipLaunchKernelGGL(mk_fwd, dim3(grid), dim3(512), LDS_BYTES, stream, a);
#endif
}
```

```cpp
#include <hip/hip_runtime.h>
#include <cstdio>
#include <cstdint>

#ifndef MK_PER_PHASE
#define MK_PER_PHASE 0
#endif

constexpr int BATCH = 8, SEQ = 4096, T = BATCH * SEQ, DM = 1024;
constexpr int NPJ = 5632;
constexpr int C_QA = 0, C_KA = 512, C_VA = 1024, C_QI = 1536, C_QM = 2048, C_KM = 2304, C_VM = 2560, C_OM = 3072, C_GA = 3584, C_GM = 4608;
constexpr int NWIN = 5888;
constexpr int NE = 32, DFF = 1024, ECAP = 32768;
constexpr float LN_EPS = 1e-5f;
constexpr float DN_ALPHA = 1.189207115002721f;
constexpr int NPHASE = 12;

constexpr size_t MiB = 1u << 20;
constexpr size_t WS_CTL = 0, CTL_BYTES = 1 * MiB;
constexpr size_t WS_WIN = 1 * MiB;
constexpr size_t WS_WCAT = 13 * MiB;
constexpr size_t WS_WO = 15 * MiB;
constexpr size_t WS_WGU = 17 * MiB;
constexpr size_t WS_WD = 145 * MiB;
constexpr size_t WS_PROJ = 209 * MiB;
constexpr size_t WS_SMALL = 561 * MiB;
constexpr size_t WS_KI = 563 * MiB;
constexpr size_t WS_NL = 567 * MiB;
constexpr size_t WS_MLBE = WS_NL + 512 * 1024;
constexpr size_t WS_TOK = 568 * MiB;
constexpr size_t WS_GATE = 572 * MiB;
constexpr size_t WS_PAIR = 576 * MiB;
constexpr size_t WS_R1 = 584 * MiB;
constexpr size_t WS_R3 = 712 * MiB;
constexpr size_t WS_XB = WS_R3;
constexpr size_t WS_MW = WS_R3;
constexpr size_t WS_YCAT = WS_R3 + 16 * MiB;
constexpr size_t WS_MIX = WS_R3 + 80 * MiB;
constexpr size_t WS_CL = WS_R3 + 144 * MiB;
constexpr size_t WS_QC = WS_R3 + 208 * MiB;
constexpr size_t WS_KC = WS_R3 + 224 * MiB;
constexpr size_t WS_Y2 = WS_R3;
constexpr size_t WS_END = 984 * MiB;
constexpr int CW_CNT = 64;
constexpr int CW_BAR = 4096;

constexpr int LDS_MISC = 150 * 1024;
constexpr int LDS_BYTES = 152 * 1024;

#define GAS __attribute__((address_space(1)))
#define LAS __attribute__((address_space(3)))
typedef unsigned short bf16_t;
typedef short bf16x8 __attribute__((ext_vector_type(8)));
typedef short s16x4 __attribute__((ext_vector_type(4)));
typedef float f32x4 __attribute__((ext_vector_type(4)));
typedef float f32x2 __attribute__((ext_vector_type(2)));
typedef float f32x16 __attribute__((ext_vector_type(16)));
typedef unsigned u32x4 __attribute__((ext_vector_type(4)));
typedef unsigned u32x2 __attribute__((ext_vector_type(2)));

__device__ __forceinline__ unsigned cvt_pk_bf16(float lo, float hi) { unsigned r; asm("v_cvt_pk_bf16_f32 %0, %1, %2" : "=v"(r) : "v"(lo), "v"(hi)); return r; }
__device__ __forceinline__ float bf2f(unsigned short b) { return __uint_as_float(((unsigned)b) << 16); }
__device__ __forceinline__ float bflo(unsigned w) { return __uint_as_float(w << 16); }
__device__ __forceinline__ float bfhi(unsigned w) { return __uint_as_float(w & 0xffff0000u); }
__device__ __forceinline__ unsigned short f2bf(float f) { return (unsigned short)(cvt_pk_bf16(f, 0.f) & 0xffffu); }
__device__ __forceinline__ float sigmoidf_(float x) { return __builtin_amdgcn_rcpf(1.f + __expf(-x)); }
__device__ __forceinline__ float wave_sum(float v) {
#pragma unroll
    for (int o = 1; o < 64; o <<= 1) v += __shfl_xor(v, o);
    return v;
}
__device__ __forceinline__ float wave_max(float v) {
#pragma unroll
    for (int o = 1; o < 64; o <<= 1) v = fmaxf(v, __shfl_xor(v, o));
    return v;
}

#define XB_TMO      128
#define XB_XCNT(j)  (256  + 64 * (j))
#define XB_XSUB(j)  (1280 + 64 * (j))
#define XB_XGEN(j)  (2304 + 64 * (j))
#define XB_TOP      3328
#define XB_TOPGEN   3392
#define XCD_BAR_WORDS 3456
#define XB_SPIN_CAP (1u << 18)
__device__ __forceinline__ unsigned xb_ld(unsigned* p)              { return __hip_atomic_load(p, __ATOMIC_RELAXED, __HIP_MEMORY_SCOPE_AGENT); }
__device__ __forceinline__ unsigned xb_add(unsigned* p, unsigned v) { return __hip_atomic_fetch_add(p, v, __ATOMIC_RELAXED, __HIP_MEMORY_SCOPE_AGENT); }
__device__ __forceinline__ unsigned xb_xcc_id() { return (unsigned)__builtin_amdgcn_s_getreg((3 << 11) | 20) & 0xFu; }
#define XB_SPIN(cond, bar) do { unsigned _sp = 0; while (cond) { __builtin_amdgcn_s_sleep(1); \
    if ((++_sp & 255u) == 0u) { if (xb_ld(&(bar)[XB_TMO])) break; if (_sp > XB_SPIN_CAP) { atomicAdd(&(bar)[XB_TMO], 1u); break; } } } } while (0)
struct XcdBarrier { unsigned* bar; unsigned x; volatile LAS unsigned* st; };
__device__ __forceinline__ XcdBarrier xcd_barrier_post(unsigned* bar, volatile LAS unsigned* st) {
    XcdBarrier b; b.bar = bar; b.x = xb_xcc_id(); b.st = st;
    if (threadIdx.x == 0) (void)xb_add(&bar[XB_XCNT(b.x)], 1u);
    return b;
}
__device__ __forceinline__ void xcd_barrier_complete(unsigned* bar, unsigned x, unsigned& nloc, unsigned& nx) {
    const unsigned G = gridDim.x * gridDim.y * gridDim.z;
    unsigned sum, cnt, mine, sp = 0u;
    for (;;) {
        sum = 0u; cnt = 0u; mine = 0u;
#pragma unroll
        for (unsigned j = 0; j < 16; ++j) { const unsigned c = xb_ld(&bar[XB_XCNT(j)]); sum += c; cnt += (c > 0u) ? 1u : 0u; mine = (j == x) ? c : mine; }
        if (sum == G) break;
        __builtin_amdgcn_s_sleep(1);
        if ((++sp & 255u) == 0u) { if (xb_ld(&bar[XB_TMO])) break; if (sp > XB_SPIN_CAP) { atomicAdd(&bar[XB_TMO], 1u); break; } }
    }
    nloc = mine > 0u ? mine : 1u; nx = cnt > 0u ? cnt : 1u;
}
__device__ __forceinline__ void xcd_barrier(const XcdBarrier& b) {
    asm volatile("s_waitcnt vmcnt(0)" ::: "memory");
    __syncthreads();
    if (threadIdx.x == 0) {
        unsigned* bar = b.bar;
        __builtin_amdgcn_s_waitcnt(0);
        unsigned nloc = b.st[0], nx = b.st[1];
        if (nloc == 0u) { xcd_barrier_complete(bar, b.x, nloc, nx); b.st[0] = nloc; b.st[1] = nx; }
        const unsigned old = xb_add(&bar[XB_XSUB(b.x)], 1u);
        const unsigned gen = old / nloc;
        if (old + 1u == (gen + 1u) * nloc) {
            __builtin_amdgcn_fence(__ATOMIC_RELEASE, "agent");
            asm volatile("s_waitcnt vmcnt(0)" ::: "memory");
            const unsigned og = xb_add(&bar[XB_TOP], 1u);
            const unsigned tg = og / nx;
            if (og + 1u == (tg + 1u) * nx) xb_add(&bar[XB_TOPGEN], 1u);
            else XB_SPIN(xb_ld(&bar[XB_TOPGEN]) == tg, bar);
            __builtin_amdgcn_fence(__ATOMIC_ACQUIRE, "agent");
            xb_add(&bar[XB_XGEN(b.x)], 1u);
            asm volatile("s_waitcnt vmcnt(0)" ::: "memory");
        } else {
            XB_SPIN(xb_ld(&bar[XB_XGEN(b.x)]) == gen, bar);
            __builtin_amdgcn_fence(__ATOMIC_ACQUIRE, "agent");
            asm volatile("s_waitcnt vmcnt(0)" ::: "memory");
        }
    }
    __syncthreads();
}

struct Frame {
    LAS unsigned char* lds;
    unsigned char* ws;
    int tid, lane, wave, G, bid;
    const float *x, *w_in, *conv_w, *conv_b, *i_bias, *f_bias, *norm_g, *w_ba, *w_bm, *w_out, *ln1_g, *ln1_b, *w_router, *b_router,
                *w_gu, *b_gu, *w_down, *b_down, *ln2_g, *ln2_b, *rel_bias;
    float* out;
};

namespace pg8 {
constexpr int BM = 256, BK = 64, HALF = 128, HTB = HALF * BK * 2, STAGE_BYTES = 8 * HTB, NXCD = 8, WGM = 8;
__host__ __device__ __forceinline__ int lds_byte(int r, int c) { const int st = (r >> 4) * 2 + (c >> 5), rr = r & 15, cc = c & 31, ob = rr * 64 + cc * 2; return st * 1024 + (ob ^ (((ob >> 9) & 1) << 5)); }
__host__ __device__ __forceinline__ void stage_rc(int b, int& R, int& C) { const int st = b / 1024, sb = b % 1024, swz = sb ^ (((sb >> 9) & 1) << 5); R = (st >> 1) * 16 + swz / 64; C = (st & 1) * 32 + (swz % 64) / 2; }
__host__ __device__ __forceinline__ int perm32(int rho) { const int n = rho >> 4, i = rho & 15; return 8 * (i >> 2) + 4 * n + (i & 3); }

struct Unit { int pm, pn, e, rt, nv; };

__device__ __forceinline__ void tile_of(int L, int nM, int nN, int& pm, int& pn) {
    const int nwg = nM * nN; int wgid = L;
    { const int q = nwg / NXCD, r = nwg % NXCD, xcd = wgid % NXCD, off = wgid / NXCD; wgid = (xcd < r ? xcd * (q + 1) : r * (q + 1) + (xcd - r) * q) + off; }
    const int nig = WGM * nN, gid = wgid / nig, fm = gid * WGM, gsz = (nM - fm) < WGM ? (nM - fm) : WGM;
    pm = fm + ((wgid % nig) % gsz); pn = (wgid % nig) / gsz;
}
struct DenseOrder {
    const char* A; const char* Bt; int lda, K, nM, nN, G, c;
    __device__ __forceinline__ bool next(int i, Unit& u) const { const long L = (long)i * G + c; if (L >= (long)nM * nN) return false; tile_of((int)L, nM, nN, u.pm, u.pn); u.e = 0; u.rt = 0; u.nv = 256; return true; }
    __device__ __forceinline__ const char* abase() const { return A; }
    __device__ __forceinline__ const char* bbase(const Unit& u) const { return Bt + (size_t)u.pn * 256 * K * 2; }
    __device__ __forceinline__ void aoffs(const Unit& u, const int (&R)[2], const int (&C)[2], unsigned (&vo)[2][2]) const {
#pragma unroll
        for (int h = 0; h < 2; ++h)
#pragma unroll
            for (int i = 0; i < 2; ++i) vo[h][i] = (unsigned)((u.pm * 256 + h * 128 + R[i]) * lda + C[i]) * 2u;
    }
};
struct MergeOrder {
    const char* A; const char* Bt; int G, c;
    __device__ __forceinline__ bool next(int i, Unit& u) const { const long L = (long)(i >> 1) * G + c; if (L >= 512) return false; tile_of((int)L, 128, 4, u.pm, u.pn); u.e = i & 1; u.rt = 0; u.nv = 256; return true; }
    __device__ __forceinline__ const char* abase() const { return A; }
    __device__ __forceinline__ const char* bbase(const Unit& u) const { return Bt + (size_t)u.e * 1024 * 512 * 2 + (size_t)u.pn * 256 * 512 * 2; }
    __device__ __forceinline__ void aoffs(const Unit& u, const int (&R)[2], const int (&C)[2], unsigned (&vo)[2][2]) const {
#pragma unroll
        for (int h = 0; h < 2; ++h)
#pragma unroll
            for (int i = 0; i < 2; ++i) vo[h][i] = (unsigned)((u.pm * 256 + h * 128 + R[i]) * 1024 + u.e * 512 + C[i]) * 2u;
    }
};
struct MoeOrder {
    const LAS int* tstart; const LAS int* cnt; const char* A; const char* Bt; const int* tok; int nct, G, c; size_t bstride; bool gather;
    __device__ __forceinline__ bool next(int i, Unit& u) const {
        const long L = (long)i * G + c; const int ntile = tstart[32]; if (L >= (long)ntile * nct) return false;
        const int gt = (int)(L / nct); int e = 0;
#pragma unroll
        for (int s = 16; s >= 1; s >>= 1) if (tstart[e + s] <= gt) e += s;
        u.pm = gt; u.pn = (int)(L % nct); u.e = e; u.rt = gt - tstart[e]; const int rem = cnt[e] - u.rt * 256; u.nv = rem < 256 ? rem : 256; return true;
    }
    __device__ __forceinline__ const char* abase() const { return A; }
    __device__ __forceinline__ const char* bbase(const Unit& u) const { return Bt + (size_t)u.e * bstride + (size_t)u.pn * 256 * 1024 * 2; }
    __device__ __forceinline__ void aoffs(const Unit& u, const int (&R)[2], const int (&C)[2], unsigned (&vo)[2][2]) const {
#pragma unroll
        for (int h = 0; h < 2; ++h)
#pragma unroll
            for (int i = 0; i < 2; ++i) {
                const int r = h * 128 + R[i]; int row;
                if (gather) { row = (r < u.nv) ? tok[u.e * ECAP + u.rt * 256 + r] : 0; } else row = u.pm * 256 + r;
                vo[h][i] = (unsigned)(row * 1024 + C[i]) * 2u;
            }
    }
};

template <class Epi, class Sched>
__device__ __forceinline__ void gemm_phase(LAS unsigned char* lds, const int K, const Sched& S, const Epi& E) {
    int tid = threadIdx.x; asm volatile("" : "+v"(tid));
    const int wid = __builtin_amdgcn_readfirstlane(tid >> 6), lane = tid & 63, wr = wid >> 2, wc = wid & 3, fr = lane & 15, fq = lane >> 4;
    const int nt = K / BK;
    int Rr[2], Cc[2]; unsigned voffB[2];
#pragma unroll
    for (int i = 0; i < 2; ++i) { int R, C; stage_rc(tid * 16 + i * 8192, R, C); const int Rb = Epi::PERM ? ((R & ~31) + perm32(R & 31)) : R; Rr[i] = R; Cc[i] = C; voffB[i] = (unsigned)(Rb * K + C) * 2u; }
    const size_t kstep = (size_t)(BK * 2);
    const size_t hstep = (size_t)HALF * K * 2;
    const unsigned ldsw = (unsigned)wid * 1024u;
    const int aoff = lds_byte(wr * 64 + fr, fq * 8), boff = lds_byte(wc * 32 + fr, fq * 8);
#define PG8_SA(b, h) (((b) * 2 + (h)) * HTB)
#define PG8_SB(b, h) ((4 + (b) * 2 + (h)) * HTB)
#define PG8_STAGEB(bufoff, gbase) do { _Pragma("unroll") for (int _i = 0; _i < 2; ++_i) \
        __builtin_amdgcn_global_load_lds((const unsigned*)((const char*)(gbase) + voffB[_i]), (LAS unsigned*)(lds + (bufoff) + ldsw + _i * 8192), 16, 0, 0); } while (0)
#define PG8_STAGEA(bufoff, kofs, v0, v1) do { \
        __builtin_amdgcn_global_load_lds((const unsigned*)(Ab + (kofs) + (v0)), (LAS unsigned*)(lds + (bufoff) + ldsw), 16, 0, 0); \
        __builtin_amdgcn_global_load_lds((const unsigned*)(Ab + (kofs) + (v1)), (LAS unsigned*)(lds + (bufoff) + ldsw + 8192), 16, 0, 0); } while (0)
#define PG8_LDA(dst, b, h) do { _Pragma("unroll") for (int m = 0; m < 4; ++m) _Pragma("unroll") for (int k = 0; k < 2; ++k) dst[m][k] = *(const LAS bf16x8*)(lds + PG8_SA(b, h) + aoff + m * 2048 + k * 1024); } while (0)
#define PG8_LDB(dst, b, h) do { _Pragma("unroll") for (int n = 0; n < 2; ++n) _Pragma("unroll") for (int k = 0; k < 2; ++k) dst[n][k] = *(const LAS bf16x8*)(lds + PG8_SB(b, h) + boff + n * 2048 + k * 1024); } while (0)
#define PG8_MMA(ai, bj, At, Bt) do { __builtin_amdgcn_s_setprio(1); _Pragma("unroll") for (int m = 0; m < 4; ++m) _Pragma("unroll") for (int n = 0; n < 2; ++n) _Pragma("unroll") for (int k = 0; k < 2; ++k) \
        acc[ai][bj][m][n] = __builtin_amdgcn_mfma_f32_16x16x32_bf16(Bt[n][k], At[m][k], acc[ai][bj][m][n], 0, 0, 0); __builtin_amdgcn_s_setprio(0); } while (0)
#define PG8_WAIT_V(n) asm volatile("s_waitcnt vmcnt(" #n ")" ::: "memory")
#define PG8_WAIT_L(n) asm volatile("s_waitcnt lgkmcnt(" #n ")" ::: "memory")
#define PG8_BAR __builtin_amdgcn_s_barrier()
#define PG8_SCHED __builtin_amdgcn_sched_barrier(0)
    Unit cur, nxt; int ui = 0;
    if (!S.next(0, cur)) return;
    f32x4 acc[2][2][4][2];
#pragma unroll
    for (int a = 0; a < 2; ++a)
#pragma unroll
        for (int b = 0; b < 2; ++b)
#pragma unroll
            for (int m = 0; m < 4; ++m)
#pragma unroll
                for (int n = 0; n < 2; ++n) acc[a][b][m][n] = (f32x4){0.f, 0.f, 0.f, 0.f};
    bf16x8 At[4][2], B0[2][2], B1[2][2];
    const char* Ab = S.abase();
    unsigned voC[2][2], voN[2][2];
    S.aoffs(cur, Rr, Cc, voC);
    const char* cB = S.bbase(cur);
    PG8_STAGEB(PG8_SB(0, 0), cB); PG8_STAGEA(PG8_SA(0, 0), 0, voC[0][0], voC[0][1]); PG8_STAGEB(PG8_SB(0, 1), cB + hstep); PG8_STAGEA(PG8_SA(0, 1), 0, voC[1][0], voC[1][1]);
    if (wr == 1) PG8_BAR;
    PG8_WAIT_V(4); PG8_BAR;
    PG8_STAGEB(PG8_SB(1, 0), cB + kstep); PG8_STAGEA(PG8_SA(1, 0), kstep, voC[0][0], voC[0][1]); PG8_STAGEB(PG8_SB(1, 1), cB + hstep + kstep);
    PG8_WAIT_V(6); PG8_BAR;
    for (;;) {
        const bool has_next = S.next(ui + 1, nxt);
        if (has_next) S.aoffs(nxt, Rr, Cc, voN);
        else {
#pragma unroll
            for (int h = 0; h < 2; ++h)
#pragma unroll
                for (int i = 0; i < 2; ++i) voN[h][i] = voC[h][i];
        }
        const char* nB = has_next ? S.bbase(nxt) : cB;
        for (int t = 0; t < nt; t += 2) {
            const bool last = (t == nt - 2);
            const size_t k1 = (size_t)(t + 1) * kstep;
            const size_t k2 = last ? 0 : (size_t)(t + 2) * kstep, k3 = k2 + kstep;
            const char* b2 = last ? nB : cB + (size_t)(t + 2) * kstep; const char* b3 = b2 + kstep;
            const unsigned a00 = last ? voN[0][0] : voC[0][0], a01 = last ? voN[0][1] : voC[0][1], a10 = last ? voN[1][0] : voC[1][0], a11 = last ? voN[1][1] : voC[1][1];
            PG8_LDB(B0, 0, 0); PG8_SCHED; PG8_LDA(At, 0, 0); PG8_STAGEA(PG8_SA(1, 1), k1, voC[1][0], voC[1][1]);
            PG8_WAIT_L(8); PG8_BAR; PG8_WAIT_L(0); PG8_MMA(0, 0, At, B0); PG8_BAR; PG8_SCHED;
            PG8_LDB(B1, 0, 1); PG8_STAGEB(PG8_SB(0, 0), b2);
            PG8_BAR; PG8_WAIT_L(0); PG8_MMA(0, 1, At, B1); PG8_BAR;
            PG8_LDA(At, 0, 1); PG8_STAGEA(PG8_SA(0, 0), k2, a00, a01);
            PG8_BAR; PG8_WAIT_L(0); PG8_MMA(1, 0, At, B0); PG8_BAR; PG8_SCHED;
            PG8_STAGEB(PG8_SB(0, 1), b2 + hstep);
            PG8_WAIT_V(6); PG8_BAR; PG8_MMA(1, 1, At, B1); PG8_BAR;
            PG8_LDB(B0, 1, 0); PG8_SCHED; PG8_LDA(At, 1, 0); PG8_STAGEA(PG8_SA(0, 1), k2, a10, a11);
            PG8_WAIT_L(8); PG8_BAR; PG8_WAIT_L(0); PG8_MMA(0, 0, At, B0); PG8_BAR; PG8_SCHED;
            PG8_LDB(B1, 1, 1); PG8_STAGEB(PG8_SB(1, 0), b3);
            PG8_BAR; PG8_WAIT_L(0); PG8_MMA(0, 1, At, B1); PG8_BAR;
            PG8_LDA(At, 1, 1); PG8_STAGEA(PG8_SA(1, 0), k3, a00, a01);
            PG8_BAR; PG8_WAIT_L(0); PG8_MMA(1, 0, At, B0); PG8_BAR; PG8_SCHED;
            PG8_STAGEB(PG8_SB(1, 1), b3 + hstep);
            PG8_WAIT_V(6); PG8_BAR; PG8_MMA(1, 1, At, B1); PG8_BAR;
        }
        E(acc, cur, wr, wc, fr, fq);
        if (!has_next) break;
#pragma unroll
        for (int a = 0; a < 2; ++a)
#pragma unroll
            for (int b = 0; b < 2; ++b)
#pragma unroll
                for (int m = 0; m < 4; ++m)
#pragma unroll
                    for (int n = 0; n < 2; ++n) acc[a][b][m][n] = (f32x4){0.f, 0.f, 0.f, 0.f};
        cur = nxt; cB = nB; ++ui;
#pragma unroll
        for (int h = 0; h < 2; ++h)
#pragma unroll
            for (int i = 0; i < 2; ++i) voC[h][i] = voN[h][i];
    }
    PG8_WAIT_V(0);
    if (wr == 0) PG8_BAR;
    PG8_BAR;
#undef PG8_SA
#undef PG8_SB
#undef PG8_STAGEA
#undef PG8_STAGEB
#undef PG8_LDA
#undef PG8_LDB
#undef PG8_MMA
#undef PG8_WAIT_V
#undef PG8_WAIT_L
#undef PG8_BAR
#undef PG8_SCHED
}
}
using pg8::Unit;

struct EpiProj {
    static constexpr bool PERM = true;
    bf16_t* proj; bf16_t* ki; float* small_;
    __device__ __forceinline__ void operator()(const f32x4 (&acc)[2][2][4][2], const Unit& u, int wr, int wc, int fr, int fq) const {
        const int row0 = u.pm * 256 + wr * 64 + fr;
        if (u.pn < 22) {
            const int col0 = u.pn * 256 + wc * 32 + 8 * fq;
#pragma unroll
            for (int ai = 0; ai < 2; ++ai)
#pragma unroll
                for (int m = 0; m < 4; ++m) { bf16_t* rowp = proj + (size_t)(row0 + ai * 128 + m * 16) * NPJ + col0;
#pragma unroll
                    for (int bj = 0; bj < 2; ++bj) { const f32x4 v0 = acc[ai][bj][m][0], v1 = acc[ai][bj][m][1];
                        u32x4 w; w.x = cvt_pk_bf16(v0[0], v0[1]); w.y = cvt_pk_bf16(v0[2], v0[3]); w.z = cvt_pk_bf16(v1[0], v1[1]); w.w = cvt_pk_bf16(v1[2], v1[3]);
                        *(u32x4*)(rowp + bj * 128) = w; } }
        } else {
#pragma unroll
            for (int ai = 0; ai < 2; ++ai)
#pragma unroll
                for (int m = 0; m < 4; ++m) { const int row = row0 + ai * 128 + m * 16; const f32x4 v0 = acc[ai][0][m][0], v1 = acc[ai][0][m][1];
                    if (wc < 2) { u32x4 w; w.x = cvt_pk_bf16(v0[0], v0[1]); w.y = cvt_pk_bf16(v0[2], v0[3]); w.z = cvt_pk_bf16(v1[0], v1[1]); w.w = cvt_pk_bf16(v1[2], v1[3]);
                        *(u32x4*)(ki + (size_t)row * 64 + wc * 32 + 8 * fq) = w; }
                    else if (wc == 2 && fq < 2) { *(f32x4*)(small_ + (size_t)row * 16 + 8 * fq) = v0; *(f32x4*)(small_ + (size_t)row * 16 + 8 * fq + 4) = v1; } }
        }
    }
};
struct EpiMerge {
    static constexpr bool PERM = true;
    const bf16_t* proj; bf16_t* mix;
    __device__ __forceinline__ void operator()(const f32x4 (&acc)[2][2][4][2], const Unit& u, int wr, int wc, int fr, int fq) const {
        const int row0 = u.pm * 256 + wr * 64 + fr, col0 = u.pn * 256 + wc * 32 + 8 * fq; const int gcol = (u.e ? C_GM : C_GA) + col0;
#pragma unroll
        for (int ai = 0; ai < 2; ++ai)
#pragma unroll
            for (int m = 0; m < 4; ++m) { const int row = row0 + ai * 128 + m * 16;
#pragma unroll
                for (int bj = 0; bj < 2; ++bj) {
                    const u32x4 g = *(const u32x4*)(proj + (size_t)row * NPJ + gcol + bj * 128);
                    bf16_t* mp = mix + (size_t)row * 1024 + col0 + bj * 128;
                    u32x4 old = (u32x4){0u, 0u, 0u, 0u}; if (u.e) old = *(const u32x4*)mp;
                    const f32x4 v0 = acc[ai][bj][m][0], v1 = acc[ai][bj][m][1];
                    float o[8];
                    o[0] = bflo(old.x) + sigmoidf_(bflo(g.x)) * v0[0]; o[1] = bfhi(old.x) + sigmoidf_(bfhi(g.x)) * v0[1];
                    o[2] = bflo(old.y) + sigmoidf_(bflo(g.y)) * v0[2]; o[3] = bfhi(old.y) + sigmoidf_(bfhi(g.y)) * v0[3];
                    o[4] = bflo(old.z) + sigmoidf_(bflo(g.z)) * v1[0]; o[5] = bfhi(old.z) + sigmoidf_(bfhi(g.z)) * v1[1];
                    o[6] = bflo(old.w) + sigmoidf_(bflo(g.w)) * v1[2]; o[7] = bfhi(old.w) + sigmoidf_(bfhi(g.w)) * v1[3];
                    u32x4 w; w.x = cvt_pk_bf16(o[0], o[1]); w.y = cvt_pk_bf16(o[2], o[3]); w.z = cvt_pk_bf16(o[4], o[5]); w.w = cvt_pk_bf16(o[6], o[7]);
                    *(u32x4*)mp = w; } }
    }
};
struct EpiOut {
    static constexpr bool PERM = false;
    const float* x; float* z;
    __device__ __forceinline__ void operator()(const f32x4 (&acc)[2][2][4][2], const Unit& u, int wr, int wc, int fr, int fq) const {
        const int row0 = u.pm * 256 + wr * 64 + fr, col0 = u.pn * 256 + wc * 32 + 4 * fq;
#pragma unroll
        for (int ai = 0; ai < 2; ++ai)
#pragma unroll
            for (int m = 0; m < 4; ++m) { const size_t off = (size_t)(row0 + ai * 128 + m * 16) * 1024 + col0;
#pragma unroll
                for (int bj = 0; bj < 2; ++bj)
#pragma unroll
                    for (int n = 0; n < 2; ++n) { const f32x4 xv = *(const f32x4*)(x + off + bj * 128 + n * 16); *(f32x4*)(z + off + bj * 128 + n * 16) = xv * DN_ALPHA + acc[ai][bj][m][n]; } }
    }
};
struct EpiGateUp {
    static constexpr bool PERM = true;
    const float* bgu; bf16_t* h;
    __device__ __forceinline__ void operator()(const f32x4 (&acc)[2][2][4][2], const Unit& u, int wr, int wc, int fr, int fq) const {
        const int row0 = u.pm * 256 + wr * 64 + fr, ff0 = u.pn * 128 + wc * 32 + 8 * fq; const float* bg = bgu + (size_t)u.e * 2048 + ff0;
        f32x4 bgate[2], bup[2];
#pragma unroll
        for (int n = 0; n < 2; ++n) { bgate[n] = *(const f32x4*)(bg + 4 * n); bup[n] = *(const f32x4*)(bg + 1024 + 4 * n); }
#pragma unroll
        for (int ai = 0; ai < 2; ++ai)
#pragma unroll
            for (int m = 0; m < 4; ++m) { float o[8];
#pragma unroll
                for (int n = 0; n < 2; ++n) { const f32x4 gt = acc[ai][0][m][n] + bgate[n], up = acc[ai][1][m][n] + bup[n];
#pragma unroll
                    for (int j = 0; j < 4; ++j) { const float g = fminf(gt[j], 7.0f), uu = fminf(fmaxf(up[j], -7.0f), 7.0f); o[4 * n + j] = (uu + 1.0f) * (g * sigmoidf_(1.702f * g)); } }
                u32x4 w; w.x = cvt_pk_bf16(o[0], o[1]); w.y = cvt_pk_bf16(o[2], o[3]); w.z = cvt_pk_bf16(o[4], o[5]); w.w = cvt_pk_bf16(o[6], o[7]);
                *(u32x4*)(h + (size_t)(row0 + ai * 128 + m * 16) * 1024 + ff0) = w; }
    }
};
struct EpiDown {
    static constexpr bool PERM = true;
    const float* bd; const float* gate; bf16_t* y2;
    __device__ __forceinline__ void operator()(const f32x4 (&acc)[2][2][4][2], const Unit& u, int wr, int wc, int fr, int fq) const {
        const int rl0 = wr * 64 + fr, col0 = u.pn * 256 + wc * 32 + 8 * fq; const float* bp = bd + (size_t)u.e * 1024 + col0;
        f32x4 bv[2][2];
#pragma unroll
        for (int bj = 0; bj < 2; ++bj)
#pragma unroll
            for (int n = 0; n < 2; ++n) bv[bj][n] = *(const f32x4*)(bp + bj * 128 + 4 * n);
#pragma unroll
        for (int ai = 0; ai < 2; ++ai)
#pragma unroll
            for (int m = 0; m < 4; ++m) { const int rl = rl0 + ai * 128 + m * 16; const float gr = (rl < u.nv) ? gate[(size_t)u.e * ECAP + u.rt * 256 + rl] : 0.f;
                bf16_t* rowp = y2 + (size_t)(u.pm * 256 + rl) * 1024 + col0;
#pragma unroll
                for (int bj = 0; bj < 2; ++bj) { const f32x4 v0 = (acc[ai][bj][m][0] + bv[bj][0]) * gr, v1 = (acc[ai][bj][m][1] + bv[bj][1]) * gr;
                    u32x4 w; w.x = cvt_pk_bf16(v0[0], v0[1]); w.y = cvt_pk_bf16(v0[2], v0[3]); w.z = cvt_pk_bf16(v1[0], v1[1]); w.w = cvt_pk_bf16(v1[2], v1[3]);
                    *(u32x4*)(rowp + bj * 128) = w; } }
    }
};

template <class SrcCol>
__device__ __forceinline__ void transpose_item(const float* W, int ldw, int K, bf16_t* WT, int n0, int k0, SrcCol sc, LAS float* scr, int lane) {
    const int c = sc(n0 + lane);
#pragma unroll 8
    for (int kk = 0; kk < 64; ++kk) scr[kk * 65 + lane] = (c >= 0) ? W[(size_t)(k0 + kk) * ldw + c] : 0.f;
    asm volatile("s_waitcnt lgkmcnt(0)" ::: "memory");
    const int ch = lane & 7;
#pragma unroll
    for (int j = 0; j < 8; ++j) { const int n = (lane >> 3) + 8 * j; const LAS float* s = scr + (8 * ch) * 65 + n;
        u32x4 o; o.x = cvt_pk_bf16(s[0 * 65], s[1 * 65]); o.y = cvt_pk_bf16(s[2 * 65], s[3 * 65]); o.z = cvt_pk_bf16(s[4 * 65], s[5 * 65]); o.w = cvt_pk_bf16(s[6 * 65], s[7 * 65]);
        *(u32x4*)(WT + (size_t)(n0 + n) * K + k0 + 8 * ch) = o; }
    asm volatile("s_waitcnt lgkmcnt(0)" ::: "memory");
}
__device__ __forceinline__ int win_srccol(int n) {
    if (n < 2048) return n;
    if (n < 2560) return n - 2048 + 2120;
    if (n < 3072) return n - 2560 + 2632;
    if (n < 3584) return n - 3072 + 3152;
    if (n < 5632) return n - 3584 + 3664;
    const int j = n - 5632;
    if (j < 64) return 2048 + j;
    if (j < 72) return 2112 + (j - 64);
    if (j < 76) return 3144 + (j - 72);
    if (j < 80) return 3148 + (j - 76);
    return -1;
}
__device__ __forceinline__ void p0_prologue(Frame& F) {
    LAS float* scr = (LAS float*)(F.lds + F.wave * 16640);
    const int gw = F.bid * 8 + F.wave, NGW = F.G * 8;
    constexpr int I_WIN = 16 * (NWIN / 64), I_CAT = 8 * 16, I_WO = 16 * 16, I_GU = 16 * 32, I_D = 16 * 16;
    constexpr int NITEMS = I_WIN + 2 * I_CAT + I_WO + NE * I_GU + NE * I_D;
    for (int it = gw; it < NITEMS; it += NGW) {
        int r = it;
        if (r < I_WIN) { const int nb = r % (NWIN / 64), kb = r / (NWIN / 64); transpose_item(F.w_in, 5712, 1024, (bf16_t*)(F.ws + WS_WIN), nb * 64, kb * 64, [](int n) { return win_srccol(n); }, scr, F.lane); continue; } r -= I_WIN;
        if (r < 2 * I_CAT) { const int wch = r / I_CAT; r -= wch * I_CAT; const int nb = r % 16, kb = r / 16;
            transpose_item(wch ? F.w_bm : F.w_ba, 1024, 512, (bf16_t*)(F.ws + WS_WCAT) + (size_t)wch * 1024 * 512, nb * 64, kb * 64, [](int n) { return n; }, scr, F.lane); continue; } r -= 2 * I_CAT;
        if (r < I_WO) { const int nb = r % 16, kb = r / 16; transpose_item(F.w_out, 1024, 1024, (bf16_t*)(F.ws + WS_WO), nb * 64, kb * 64, [](int n) { return n; }, scr, F.lane); continue; } r -= I_WO;
        if (r < NE * I_GU) { const int e = r / I_GU; r -= e * I_GU; const int nb = r % 32, kb = r / 32;
            transpose_item(F.w_gu + (size_t)e * 1024 * 2048, 2048, 1024, (bf16_t*)(F.ws + WS_WGU) + (size_t)e * 2048 * 1024, nb * 64, kb * 64,
                           [](int n) { return ((n >> 7) & 1) * 1024 + (n >> 8) * 128 + (n & 127); }, scr, F.lane); continue; } r -= NE * I_GU;
        { const int e = r / I_D; r -= e * I_D; const int nb = r % 16, kb = r / 16;
            transpose_item(F.w_down + (size_t)e * 1024 * 1024, 1024, 1024, (bf16_t*)(F.ws + WS_WD) + (size_t)e * 1024 * 1024, nb * 64, kb * 64, [](int n) { return n; }, scr, F.lane); }
    }
    const f32x4* xs = (const f32x4*)F.x; u32x4* xd = (u32x4*)(F.ws + WS_XB);
    for (size_t i = (size_t)F.bid * 512 + F.tid; i < (size_t)T * 1024 / 8; i += (size_t)F.G * 512) {
        const f32x4 a = xs[2 * i], b = xs[2 * i + 1]; u32x4 w; w.x = cvt_pk_bf16(a[0], a[1]); w.y = cvt_pk_bf16(a[2], a[3]); w.z = cvt_pk_bf16(b[0], b[1]); w.w = cvt_pk_bf16(b[2], b[3]); xd[i] = w; }
}

__device__ __forceinline__ unsigned score_key(float v) { unsigned u = __float_as_uint(v); if (u == 0x80000000u) u = 0u; return (u & 0x80000000u) ? ~u : (u | 0x80000000u); }
__device__ __forceinline__ int crow(int r, int hi) { return (r & 3) + 8 * (r >> 2) + 4 * hi; }

template <int NVT>
__device__ __forceinline__ unsigned long long select_query(const float* row, int t, int lane) {
    unsigned key[NVT];
#pragma unroll
    for (int j = 0; j < NVT; ++j) { const int s = 64 * j + lane; const float v = row[s < t ? s : t]; key[j] = (s <= t) ? score_key(v) : 0u; }
    unsigned thr = 0u; int need = 0;
    if (t >= 256) {
        for (int bit = 31; bit >= 0; --bit) {
            const unsigned cand = thr | (1u << bit); int c = 0;
#pragma unroll
            for (int j = 0; j < NVT; ++j) { c += __popcll(__ballot(key[j] >= cand)); if ((j & 3) == 3) asm volatile("" : "+s"(c)); }
            if (c >= 256) thr = cand;
        }
        int cg = 0;
#pragma unroll
        for (int j = 0; j < NVT; ++j) { cg += __popcll(__ballot(key[j] > thr)); if ((j & 3) == 3) asm volatile("" : "+s"(cg)); }
        need = 256 - cg;
    }
    unsigned mylo = 0u, myhi = 0u; int eq_seen = 0;
#pragma unroll
    for (int j = 0; j < NVT; ++j) {
        bool sel;
        if (t >= 256) { const bool gt = key[j] > thr, eq = key[j] == thr; const unsigned long long bm = __ballot(eq);
            const int rank = eq_seen + (int)__builtin_amdgcn_mbcnt_hi((unsigned)(bm >> 32), __builtin_amdgcn_mbcnt_lo((unsigned)bm, 0u)); sel = gt || (eq && rank < need); eq_seen += __popcll(bm); }
        else sel = (64 * j + lane) <= t;
        const unsigned long long w = __ballot(sel);
        { int lj = lane; asm volatile("" : "+v"(lj)); if (lj == j) { mylo = (unsigned)w; myhi = (unsigned)(w >> 32); } }
        asm volatile("" : "+s"(eq_seen));
    }
    return ((unsigned long long)myhi << 32) | mylo;
}

__device__ __forceinline__ void idx_unit(Frame& F, int b, int qb) {
    const bf16_t* proj = (const bf16_t*)(F.ws + WS_PROJ); const bf16_t* ki = (const bf16_t*)(F.ws + WS_KI); const float* small_ = (const float*)(F.ws + WS_SMALL);
    float* sc = (float*)(F.ws + WS_R1) + (size_t)F.bid * 32 * 4096;
    const int lane = F.lane, w = F.wave, qg = w & 3, kp = w >> 2, r32 = lane & 31, hi = lane >> 5;
    const int rowbase = b * SEQ, q0 = qb * 32;
    bf16x8 af[2][4];
    { const int tokq = rowbase + q0 + 8 * qg + (r32 >> 2);
#pragma unroll
      for (int ht = 0; ht < 2; ++ht)
#pragma unroll
          for (int ks = 0; ks < 4; ++ks) af[ht][ks] = *(const bf16x8*)(proj + (size_t)tokq * NPJ + C_QI + (4 * ht + (r32 & 3)) * 64 + 16 * ks + 8 * hi); }
    float wv[4][8];
#pragma unroll
    for (int g = 0; g < 4; ++g) { const float* wp = small_ + (size_t)(rowbase + q0 + 8 * qg + 2 * g + hi) * 16; const f32x4 a = *(const f32x4*)wp, bq = *(const f32x4*)(wp + 4);
        wv[g][0] = a[0]; wv[g][1] = a[1]; wv[g][2] = a[2]; wv[g][3] = a[3]; wv[g][4] = bq[0]; wv[g][5] = bq[1]; wv[g][6] = bq[2]; wv[g][7] = bq[3]; }
    const int nkt = qb + 1;
    for (int kt = kp; kt < nkt; kt += 2) {
        const bf16_t* kpz = ki + (size_t)(rowbase + kt * 32 + r32) * 64 + 8 * hi;
        bf16x8 bfr[4];
#pragma unroll
        for (int ks = 0; ks < 4; ++ks) bfr[ks] = *(const bf16x8*)(kpz + 16 * ks);
        f32x16 a0 = {0.f}, a1 = {0.f};
#pragma unroll
        for (int ks = 0; ks < 4; ++ks) { a0 = __builtin_amdgcn_mfma_f32_32x32x16_bf16(af[0][ks], bfr[ks], a0, 0, 0, 0); a1 = __builtin_amdgcn_mfma_f32_32x32x16_bf16(af[1][ks], bfr[ks], a1, 0, 0, 0); }
#pragma unroll
        for (int g = 0; g < 4; ++g) { float s = 0.f;
#pragma unroll
            for (int j = 0; j < 4; ++j) { s += wv[g][j] * fmaxf(a0[4 * g + j], 0.f); s += wv[g][4 + j] * fmaxf(a1[4 * g + j], 0.f); }
            sc[(size_t)(8 * qg + 2 * g + hi) * 4096 + kt * 32 + r32] = s; }
    }
    __syncthreads();
    LAS unsigned long long* lw = (LAS unsigned long long*)F.lds;
#pragma unroll 1
    for (int i = 0; i < 4; ++i) {
        const int ql = 4 * w + i, t = q0 + ql; const float* row = sc + (size_t)ql * 4096; unsigned long long word;
        if (t < 512) word = select_query<8>(row, t, lane);
        else if (t < 1024) word = select_query<16>(row, t, lane);
        else if (t < 2048) word = select_query<32>(row, t, lane);
        else word = select_query<64>(row, t, lane);
        lw[lane * 32 + ql] = ~word;
    }
    __syncthreads();
    { unsigned long long* mw = (unsigned long long*)(F.ws + WS_MW) + (size_t)(b * 128 + qb) * 2048;
      for (int i = F.tid; i < 2048; i += 512) mw[i] = lw[i]; }
    __syncthreads();
}

__device__ __forceinline__ float log_sigmoidf_(float x) { return fminf(x, 0.f) - log1pf(expf(-fabsf(x))); }
__device__ __forceinline__ float wave_incl_scan(float v, int lane) {
#pragma unroll
    for (int o = 1; o < 64; o <<= 1) { const float u = __shfl_up(v, o); if (lane >= o) v += u; }
    return v;
}
__device__ __forceinline__ void chunk_gates(Frame& F, int tb, int h, int lane, float& bcum, float& li) {
    const float* small_ = (const float*)(F.ws + WS_SMALL);
    const float fp = small_[(size_t)(tb + lane) * 16 + 12 + h] + F.f_bias[h];
    li = small_[(size_t)(tb + lane) * 16 + 8 + h] + F.i_bias[h];
    bcum = wave_incl_scan(log_sigmoidf_(fp), lane);
}
__device__ __forceinline__ int sperm(int s) { return (s & ~12) | ((s & 4) << 1) | ((s & 8) >> 1); }

__device__ __forceinline__ void mlstm_local_unit(Frame& F, int b, int c) {
    const bf16_t* proj = (const bf16_t*)(F.ws + WS_PROJ);
    bf16_t* qc = (bf16_t*)(F.ws + WS_QC); bf16_t* kc = (bf16_t*)(F.ws + WS_KC);
    float* cl = (float*)(F.ws + WS_CL); float* nl = (float*)(F.ws + WS_NL); float* mlbe = (float*)(F.ws + WS_MLBE);
    const int tid = F.tid, lane = F.lane, w = F.wave; const int tb = b * SEQ + c * 64; const int cidx = (b * 64 + c) * 4;
    LAS bf16_t* KT = (LAS bf16_t*)F.lds;
    LAS bf16_t* VT = (LAS bf16_t*)(F.lds + 36864);
    LAS float* WL = (LAS float*)(F.lds + 36864 + 73728);
    if (w < 4) { float bc, li; chunk_gates(F, tb, w, lane, bc, li);
        const float bend = __shfl(bc, 63); const float a = bend - bc + li; const float ml = wave_max(a);
        WL[w * 64 + lane] = __expf(a - ml);
        if (lane == 0) { mlbe[cidx + w] = ml; mlbe[2048 + cidx + w] = bend; } }
    for (int i = tid; i < 64 * 64; i += 512) { const int l = i >> 6, v8 = (i & 63) * 8; const bf16x8 vv = *(const bf16x8*)(proj + (size_t)(tb + l) * NPJ + C_VM + v8);
        const int hh = v8 >> 7, vl = v8 & 127;
#pragma unroll
        for (int j = 0; j < 8; ++j) VT[(hh * 128 + vl + j) * 72 + l] = (bf16_t)vv[j]; }
    __syncthreads();
    { const int ch = tid; const float w0 = F.conv_w[ch], w1 = F.conv_w[512 + ch], w2 = F.conv_w[1024 + ch], w3 = F.conv_w[1536 + ch], cb = F.conv_b[ch];
      const bf16_t* xp = proj + (size_t)tb * NPJ + C_QM + ch;
      float x0 = 0.f, x1 = 0.f, x2 = 0.f;
      if (c > 0) { x0 = bf2f(xp[-3 * NPJ]); x1 = bf2f(xp[-2 * NPJ]); x2 = bf2f(xp[-1 * NPJ]); }
      const bool isk = ch >= 256; const int kch = ch - 256, hh = kch >> 6, kd = kch & 63; float nacc = 0.f;
#pragma unroll 4
      for (int l = 0; l < 64; ++l) { const float x3 = bf2f(xp[(size_t)l * NPJ]); float y = cb + w0 * x0 + w1 * x1 + w2 * x2 + w3 * x3; y = y * sigmoidf_(y);
          x0 = x1; x1 = x2; x2 = x3;
          if (!isk) qc[(size_t)(tb + l) * 256 + ch] = f2bf(y);
          else { y *= 0.125f; const unsigned short yb = f2bf(y); kc[(size_t)(tb + l) * 256 + kch] = yb; const float wl = WL[hh * 64 + l]; const float wk = wl * bf2f(yb); nacc += wk; KT[(hh * 64 + kd) * 72 + l] = f2bf(wk); } }
      if (isk) nl[(size_t)(cidx + hh) * 64 + kd] = nacc; }
    __syncthreads();
    { const int hh = w >> 1, sub = w & 1, r32 = lane & 31, hi = lane >> 5;
#pragma unroll
      for (int kt = 0; kt < 2; ++kt)
#pragma unroll
          for (int vt = 0; vt < 2; ++vt) { f32x16 acc = {0.f};
#pragma unroll
              for (int ks = 0; ks < 4; ++ks) { const bf16x8 a = *(const LAS bf16x8*)(KT + (hh * 64 + 32 * kt + r32) * 72 + 16 * ks + 8 * hi);
                  const bf16x8 bb = *(const LAS bf16x8*)(VT + (hh * 128 + 64 * sub + 32 * vt + r32) * 72 + 16 * ks + 8 * hi);
                  acc = __builtin_amdgcn_mfma_f32_32x32x16_bf16(a, bb, acc, 0, 0, 0); }
              float* dst = cl + ((size_t)(cidx + hh) * 128 + 64 * sub + 32 * vt + r32) * 64 + 32 * kt + 4 * hi;
#pragma unroll
              for (int g = 0; g < 4; ++g) *(f32x4*)(dst + 8 * g) = (f32x4){acc[4 * g], acc[4 * g + 1], acc[4 * g + 2], acc[4 * g + 3]}; } }
    __syncthreads();
}

__device__ __forceinline__ void mlstm_scan(Frame& F) {
    float* cl = (float*)(F.ws + WS_CL); float* nl = (float*)(F.ws + WS_NL); float* mlbe = (float*)(F.ws + WS_MLBE);
    constexpr int PER = 8192 + 64, TOTAL = 32 * PER;
    for (int e = F.bid * 512 + F.tid; e < TOTAL; e += F.G * 512) {
        const int bh = e / PER, off = e % PER, b = bh >> 2, h = bh & 3;
        float m = 0.f, st = 0.f;
#pragma unroll 1
        for (int cb = 0; cb < 8; ++cb) {
            float v[8], ml[8], be[8];
#pragma unroll
            for (int j = 0; j < 8; ++j) { const int idx = (b * 64 + cb * 8 + j) * 4 + h; float* p = (off < 8192) ? (cl + (size_t)idx * 8192 + off) : (nl + (size_t)idx * 64 + (off - 8192)); v[j] = *p; ml[j] = mlbe[idx]; be[j] = mlbe[2048 + idx]; }
#pragma unroll
            for (int j = 0; j < 8; ++j) { const int idx = (b * 64 + cb * 8 + j) * 4 + h; float* p = (off < 8192) ? (cl + (size_t)idx * 8192 + off) : (nl + (size_t)idx * 64 + (off - 8192));
                const float mn = fmaxf(be[j] + m, ml[j]); const float dec = __expf(be[j] + m - mn), inj = __expf(ml[j] - mn);
                *p = st; if (off == 0) mlbe[4096 + idx] = m;
                st = dec * st + inj * v[j]; m = mn; }
        }
    }
}

__device__ __forceinline__ void mlstm_out_unit(Frame& F, int b, int c) {
    const bf16_t* proj = (const bf16_t*)(F.ws + WS_PROJ);
    const bf16_t* qc = (const bf16_t*)(F.ws + WS_QC); const bf16_t* kc = (const bf16_t*)(F.ws + WS_KC);
    const float* cl = (const float*)(F.ws + WS_CL); const float* nl = (const float*)(F.ws + WS_NL); const float* mlbe = (const float*)(F.ws + WS_MLBE);
    bf16_t* ycat = (bf16_t*)(F.ws + WS_YCAT);
    const int tid = F.tid, lane = F.lane, w = F.wave; const int tb = b * SEQ + c * 64; const int cidx = (b * 64 + c) * 4;
    LAS bf16_t* VT = (LAS bf16_t*)F.lds;
    LAS float* BL = (LAS float*)(F.lds + 73728);
    LAS float* LI = BL + 256;
    LAS float* N0 = LI + 256;
    if (w < 4) { float bc, li; chunk_gates(F, tb, w, lane, bc, li); BL[w * 64 + lane] = bc; LI[w * 64 + lane] = li; N0[w * 64 + lane] = nl[(size_t)(cidx + w) * 64 + lane]; }
    for (int i = tid; i < 64 * 64; i += 512) { const int l = i >> 6, v8 = (i & 63) * 8; const bf16x8 vv = *(const bf16x8*)(proj + (size_t)(tb + l) * NPJ + C_VM + v8);
        const int hh = v8 >> 7, vl = v8 & 127, lp = sperm(l);
#pragma unroll
        for (int j = 0; j < 8; ++j) VT[(hh * 128 + vl + j) * 72 + lp] = (bf16_t)vv[j]; }
    __syncthreads();
    const int hh = w >> 1, sub = w & 1, r32 = lane & 31, hi = lane >> 5;
    const int tq = 32 * sub + r32;
    const float m0 = mlbe[4096 + cidx + hh];
    const float bt = BL[hh * 64 + tq];
    bf16x8 qf[4];
#pragma unroll
    for (int ks = 0; ks < 4; ++ks) qf[ks] = *(const bf16x8*)(qc + (size_t)(tb + tq) * 256 + hh * 64 + 16 * ks + 8 * hi);
    f32x16 sT[2]; sT[0] = (f32x16){0.f}; sT[1] = (f32x16){0.f};
#pragma unroll
    for (int st = 0; st < 2; ++st) if (st <= sub) {
#pragma unroll
        for (int ks = 0; ks < 4; ++ks) { const bf16x8 kf = *(const bf16x8*)(kc + (size_t)(tb + 32 * st + r32) * 256 + hh * 64 + 16 * ks + 8 * hi);
            sT[st] = __builtin_amdgcn_mfma_f32_32x32x16_bf16(kf, qf[ks], sT[st], 0, 0, 0); } }
    float mi = -INFINITY;
#pragma unroll
    for (int st = 0; st < 2; ++st)
#pragma unroll
        for (int r = 0; r < 16; ++r) { const int s = 32 * st + crow(r, hi); float d = -INFINITY; if (st <= sub && s <= tq) d = bt - BL[hh * 64 + s] + LI[hh * 64 + s]; mi = fmaxf(mi, d); }
    mi = fmaxf(mi, __shfl_xor(mi, 32));
    const float minter = bt + m0; const float mt = fmaxf(minter, mi);
    float psum = 0.f;
#pragma unroll
    for (int st = 0; st < 2; ++st)
#pragma unroll
        for (int r = 0; r < 16; ++r) { const int s = 32 * st + crow(r, hi); float d = -INFINITY; if (st <= sub && s <= tq) d = bt - BL[hh * 64 + s] + LI[hh * 64 + s];
            const float p = sT[st][r] * __expf(d - mt); sT[st][r] = p; psum += p; }
    psum += __shfl_xor(psum, 32);
    const float sci = __expf(minter - mt);
    float qn = 0.f;
#pragma unroll
    for (int ks = 0; ks < 4; ++ks)
#pragma unroll
        for (int j = 0; j < 8; ++j) qn += bf2f((unsigned short)qf[ks][j]) * N0[hh * 64 + 16 * ks + 8 * hi + j];
    qn += __shfl_xor(qn, 32);
    const float den = psum + sci * qn; const float rden = 1.0f / fmaxf(fabsf(den), __expf(-mt));
    bf16x8 pf[2][2];
#pragma unroll
    for (int st = 0; st < 2; ++st)
#pragma unroll
        for (int k2 = 0; k2 < 2; ++k2) { u32x4 pk; pk.x = cvt_pk_bf16(sT[st][8 * k2], sT[st][8 * k2 + 1]); pk.y = cvt_pk_bf16(sT[st][8 * k2 + 2], sT[st][8 * k2 + 3]);
            pk.z = cvt_pk_bf16(sT[st][8 * k2 + 4], sT[st][8 * k2 + 5]); pk.w = cvt_pk_bf16(sT[st][8 * k2 + 6], sT[st][8 * k2 + 7]); pf[st][k2] = __builtin_bit_cast(bf16x8, pk); }
    bf16x8 qs[4];
#pragma unroll
    for (int ks = 0; ks < 4; ++ks) { u32x4 pk;
        pk.x = cvt_pk_bf16(sci * bf2f((unsigned short)qf[ks][0]), sci * bf2f((unsigned short)qf[ks][1])); pk.y = cvt_pk_bf16(sci * bf2f((unsigned short)qf[ks][2]), sci * bf2f((unsigned short)qf[ks][3]));
        pk.z = cvt_pk_bf16(sci * bf2f((unsigned short)qf[ks][4]), sci * bf2f((unsigned short)qf[ks][5])); pk.w = cvt_pk_bf16(sci * bf2f((unsigned short)qf[ks][6]), sci * bf2f((unsigned short)qf[ks][7]));
        qs[ks] = __builtin_bit_cast(bf16x8, pk); }
    f32x16 o[4];
#pragma unroll
    for (int vt = 0; vt < 4; ++vt) { f32x16 acc = {0.f};
#pragma unroll
        for (int st = 0; st < 2; ++st) if (st <= sub) {
#pragma unroll
            for (int k2 = 0; k2 < 2; ++k2) { const bf16x8 a = *(const LAS bf16x8*)(VT + (hh * 128 + 32 * vt + r32) * 72 + 32 * st + 16 * k2 + 8 * hi);
                acc = __builtin_amdgcn_mfma_f32_32x32x16_bf16(a, pf[st][k2], acc, 0, 0, 0); } }
        const float* cp = cl + ((size_t)(cidx + hh) * 128 + 32 * vt + r32) * 64 + 8 * hi;
#pragma unroll
        for (int ks = 0; ks < 4; ++ks) { const f32x4 c0 = *(const f32x4*)(cp + 16 * ks), c1 = *(const f32x4*)(cp + 16 * ks + 4);
            u32x4 pk; pk.x = cvt_pk_bf16(c0[0], c0[1]); pk.y = cvt_pk_bf16(c0[2], c0[3]); pk.z = cvt_pk_bf16(c1[0], c1[1]); pk.w = cvt_pk_bf16(c1[2], c1[3]);
            acc = __builtin_amdgcn_mfma_f32_32x32x16_bf16(__builtin_bit_cast(bf16x8, pk), qs[ks], acc, 0, 0, 0); }
        o[vt] = acc; }
    float s1 = 0.f;
#pragma unroll
    for (int vt = 0; vt < 4; ++vt)
#pragma unroll
        for (int r = 0; r < 16; ++r) { o[vt][r] *= rden; s1 += o[vt][r]; }
    s1 += __shfl_xor(s1, 32); const float mu = s1 * (1.f / 128.f); float s2 = 0.f;
#pragma unroll
    for (int vt = 0; vt < 4; ++vt)
#pragma unroll
        for (int r = 0; r < 16; ++r) { const float d = o[vt][r] - mu; s2 += d * d; }
    s2 += __shfl_xor(s2, 32); const float rstd = 1.0f / sqrtf(s2 * (1.f / 128.f) + LN_EPS);
    const bf16_t* omp = proj + (size_t)(tb + tq) * NPJ + C_OM + hh * 128; bf16_t* yp = ycat + (size_t)(tb + tq) * 1024 + 512 + hh * 128; const float* ng = F.norm_g + hh * 128;
#pragma unroll
    for (int vt = 0; vt < 4; ++vt)
#pragma unroll
        for (int g = 0; g < 4; ++g) { const int v0 = 32 * vt + 8 * g + 4 * hi; const u32x2 om = *(const u32x2*)(omp + v0); const f32x4 gg = *(const f32x4*)(ng + v0);
            const float y0 = (o[vt][4 * g] - mu) * rstd * gg[0] * sigmoidf_(bflo(om.x)), y1 = (o[vt][4 * g + 1] - mu) * rstd * gg[1] * sigmoidf_(bfhi(om.x));
            const float y2 = (o[vt][4 * g + 2] - mu) * rstd * gg[2] * sigmoidf_(bflo(om.y)), y3 = (o[vt][4 * g + 3] - mu) * rstd * gg[3] * sigmoidf_(bfhi(om.y));
            u32x2 wv; wv.x = cvt_pk_bf16(y0, y1); wv.y = cvt_pk_bf16(y2, y3); *(u32x2*)(yp + v0) = wv; }
    __syncthreads();
}

namespace at64 {
constexpr int D = 64, PD = NPJ, OD = 1024, NW = 8, QBLK = 32, QB = QBLK * NW, KVBLK = 64;
constexpr float C2 = 0.125f * 1.4426950408889634f;
constexpr int SLOTB = 8192, LDS_K = 0, LDS_V = 3 * SLOTB, LDS_WS = 6 * SLOTB, LDS_OST = LDS_WS + NW * 256, LDS_BODY = LDS_OST + NW * 4096;
constexpr int LDS_BT = 86016;
constexpr int ATHR = 8;
#define SBAR() __builtin_amdgcn_sched_barrier(0)
#define PIN(x) asm volatile("" : "+v"(x))
#define MFMA(a, b, c) __builtin_amdgcn_mfma_f32_32x32x16_bf16(a, b, c, 0, 0, 0)
#define WAIT_BAR(N) asm volatile("s_waitcnt vmcnt(" #N ") lgkmcnt(0)\n\ts_barrier" ::: "memory")
__device__ __forceinline__ unsigned cvtpk(float lo, float hi) { unsigned r; asm("v_cvt_pk_bf16_f32 %0, %1, %2" : "=v"(r) : "v"(lo), "v"(hi)); return r; }
__device__ __forceinline__ void glds16(const void* g, unsigned lds_base) {
    unsigned sv; asm volatile("s_mov_b32 %0, m0\n\ts_mov_b32 m0, %2\n\ts_nop 0\n\tglobal_load_lds_dwordx4 %1, off\n\ts_mov_b32 m0, %0" : "=&s"(sv) : "v"(g), "s"(lds_base) : "memory"); }
typedef __attribute__((address_space(3))) const char* lds_cptr;
typedef short v4i16_t __attribute__((ext_vector_type(4)));
__device__ __forceinline__ void kload2(bf16x8* kf, lds_cptr kp, int d0) { kf[2 * d0] = *(const __attribute__((address_space(3))) bf16x8*)(kp + d0 * 2048); kf[2 * d0 + 1] = *(const __attribute__((address_space(3))) bf16x8*)(kp + d0 * 2048 + 512); }
__device__ __forceinline__ s16x4 vtr(lds_cptr p) { return __builtin_bit_cast(s16x4, __builtin_amdgcn_ds_read_tr16_b64_v4i16((__attribute__((address_space(3))) v4i16_t*)p)); }
#define MX3(a, b, c) __builtin_fmaxf(__builtin_fmaxf((a), (b)), (c))
__device__ __forceinline__ float rowmax(const f32x16& p0, const f32x16& p1) {
    float a = MX3(p0[0], p0[1], p1[0]), b = MX3(p0[2], p0[3], p1[1]); a = MX3(a, p1[2], p1[3]);
#pragma unroll
    for (int r = 4; r < 16; r += 4) { a = MX3(a, p0[r], p0[r + 1]); b = MX3(b, p0[r + 2], p0[r + 3]); a = MX3(a, p1[r], p1[r + 1]); b = MX3(b, p1[r + 2], p1[r + 3]); }
    float m = __builtin_fmaxf(a, b); auto rr = __builtin_amdgcn_permlane32_swap(__float_as_uint(m), __float_as_uint(m), false, false);
    return __builtin_fmaxf(__uint_as_float(rr[0]), __uint_as_float(rr[1])); }
__device__ __forceinline__ void maskinit(f32x16& p0, f32x16& p1, unsigned long long mw, int hi) {
    const unsigned lo = (unsigned)mw >> (4 * hi), hh = (unsigned)(mw >> 32) >> (4 * hi);
#pragma unroll
    for (int r = 0; r < 16; ++r) { const int pos = (r & 3) + 8 * (r >> 2);
        p0[r] = __uint_as_float((unsigned)((int)(lo << (31 - pos)) >> 31) & 0xff800000u); p1[r] = __uint_as_float((unsigned)((int)(hh << (31 - pos)) >> 31) & 0xff800000u); } }
__device__ __forceinline__ void bandfix(f32x16& p0, f32x16& p1, int jb, int qrel, int hi, const LAS float* bt) {
    int kb = qrel - 64 * jb - 4 * hi; SBAR(); PIN(kb);
#pragma unroll
    for (int r = 0; r < 16; ++r) { const int d0 = kb - ((r & 3) + 8 * (r >> 2)), d1 = d0 - 32;
        p0[r] += bt[d0 < 0 ? 0 : (d0 > 127 ? 127 : d0)]; p1[r] += bt[d1 < 0 ? 0 : (d1 > 127 ? 127 : d1)];
        if ((r & 3) == 3) { PIN(p0); PIN(p1); PIN(kb); SBAR(); } } }

__device__ __forceinline__ void attn64_unit(int b, int h, int qb, const bf16_t* Q, const bf16_t* __restrict__ K, const bf16_t* __restrict__ V, bf16_t* O, const unsigned long long* MW, char* lds, const LAS float* bt_all) {
    int tid = threadIdx.x; asm volatile("" : "+v"(tid)); const int lane = tid & 63, r32 = lane & 31, hi = lane >> 5; const int wid = __builtin_amdgcn_readfirstlane(tid >> 6);
    const long rowbase = (long)b * SEQ; const int q0 = qb * QB, NT = (q0 + QB) / KVBLK;
    const bf16_t* Qw = Q + (rowbase + q0 + wid * QBLK) * PD + h * D;
    const unsigned lds0 = (unsigned)(uintptr_t)lds; float* wsf = (float*)(lds + LDS_WS) + wid * 64;
    const LAS float* bt = bt_all + h * 128;
    const unsigned long long* mwp = MW + ((size_t)(b * 128 + qb * 8 + wid) * 64) * 32 + r32;
    const bf16_t* ksrc = K + rowbase * PD + h * D + (long)lane * PD + wid * 8;
    const bf16_t* vsrc = V + rowbase * PD + h * D + (long)(16 * (wid & 3) + (lane >> 2)) * PD + (wid >> 2) * 32 + (lane & 3) * 8;
    const unsigned kdst = lds0 + LDS_K + wid * 1024, vdst = lds0 + LDS_V + wid * 1024;
#define DMA_K(t, slot) glds16(ksrc + (long)(t) * KVBLK * PD, (unsigned)__builtin_amdgcn_readfirstlane(kdst + (slot)))
#define DMA_V(t, slot) glds16(vsrc + (long)(t) * KVBLK * PD, (unsigned)__builtin_amdgcn_readfirstlane(vdst + (slot)))
    const lds_cptr vp0 = (lds_cptr)lds + LDS_V + ((lane >> 4) & 1) * 32 + (lane & 3) * 8 + (4 * hi + ((lane & 15) >> 2)) * 64;
    const lds_cptr kp0 = (lds_cptr)lds + LDS_K + hi * 1024 + r32 * 16;
    DMA_K(0, 0); DMA_V(0, 0); DMA_K(1, SLOTB);
    bf16x8 qr[4];
#pragma unroll
    for (int d0 = 0; d0 < 4; ++d0) qr[d0] = *reinterpret_cast<const bf16x8*>(&Qw[(long)r32 * PD + d0 * 16 + hi * 8]);
    unsigned long long mwc = mwp[0], mwn = mwp[32];
    float mhat = 0.f, l_reg = 0.f; f32x16 o[2]; o[0] = f32x16{}; o[1] = f32x16{};
    const int qrel = wid * QBLK + r32; bool resc = false;
    f32x16 pA0, pA1, pB0, pB1; bf16x8 kf[8]; s16x4 vlo[8], vhi[8]; u32x4 pw0, pw1, pw2, pw3;
    int sl_prev = 0, sl_cur = 0, sl_next = SLOTB;
#define ROT() do { sl_prev = sl_cur; sl_cur = sl_next; sl_next = (sl_next == 2 * SLOTB) ? 0 : sl_next + SLOTB; } while (0)
#define EX(v) __builtin_amdgcn_exp2f(__builtin_fmaf((v), C2, nmh))
#define RESC() do { if (resc) { _Pragma("unroll") for (int d_ = 0; d_ < 2; ++d_) _Pragma("unroll") for (int r = 0; r < 16; ++r) o[d_][r] *= wsf[crow(r, hi)]; } } while (0)
    DMA_K(2, 2 * SLOTB);
    WAIT_BAR(3);
    _Pragma("unroll") for (int d0 = 0; d0 < 4; ++d0) kload2(kf, kp0, d0);
    maskinit(pA0, pA1, mwc, hi); mwc = mwn;
    pA0 = MFMA(kf[0], qr[0], pA0); pA1 = MFMA(kf[1], qr[0], pA1); pA0 = MFMA(kf[2], qr[1], pA0); pA1 = MFMA(kf[3], qr[1], pA1);
    pA0 = MFMA(kf[4], qr[2], pA0); pA1 = MFMA(kf[5], qr[2], pA1); pA0 = MFMA(kf[6], qr[3], pA0); pA1 = MFMA(kf[7], qr[3], pA1);
    if (NT == 4) bandfix(pA0, pA1, 0, qrel, hi, bt);
    { const float rm = rowmax(pA0, pA1); mhat = __builtin_fmaxf(rm * C2, -1.0e4f); const float nmh = -mhat;
#pragma unroll
      for (int r = 0; r < 16; ++r) { pA0[r] = EX(pA0[r]); pA1[r] = EX(pA1[r]); } }
    WAIT_BAR(0);
    DMA_K(3, 0); DMA_V(1, SLOTB); ROT();
    _Pragma("unroll") for (int d0 = 0; d0 < 4; ++d0) kload2(kf, kp0 + sl_cur, d0);
    WAIT_BAR(2);
#define PKW(P, i) cvtpk(P[i], P[i + 1])
#define PAF(k) __builtin_bit_cast(bf16x8, pw##k)
#define VFR(i) (bf16x8){vlo[i][0], vlo[i][1], vlo[i][2], vlo[i][3], vhi[i][0], vhi[i][1], vhi[i][2], vhi[i][3]}
#define VRD(i) do { vlo[i] = vtr(vp_ + (((i) >> 2) * 4096 + ((i) & 3) * 1024)); vhi[i] = vtr(vp_ + (((i) >> 2) * 4096 + ((i) & 3) * 1024 + 512)); } while (0)
#define KRD(G, d0) do { if (G) { kload2(kf, kp0 + sl_next, d0); SBAR(); } } while (0)
#define GAPA(MF, a0, a1, a2, a3, W0, W1, PW) do { MF; sacc += a0; sacc += a1; sacc += a2; sacc += a3; W0; W1; PIN(PW); PIN(sacc); SBAR(); } while (0)
#define GAPB(MF, X, i) do { MF; X[i] = EX(X[i]); X[i + 1] = EX(X[i + 1]); X[i + 2] = EX(X[i + 2]); X[i + 3] = EX(X[i + 3]); PIN(X); SBAR(); } while (0)
#define STEP(C0, C1, P0, P1, t, MASK, GK, GV, GL) do { SBAR(); \
    const lds_cptr vp_ = vp0 + sl_prev; maskinit(C0, C1, mwc, hi); mwc = mwp[(size_t)(((t) + 1) > 63 ? 63 : ((t) + 1)) * 32]; SBAR(); \
    VRD(0); SBAR(); float sacc = P0[0] + P0[1]; \
                    GAPA(C0 = MFMA(kf[0], qr[0], C0),     P0[2], P0[3], P0[4], P0[5],     pw0[0] = PKW(P0, 0),  pw0[1] = PKW(P0, 2),  pw0); \
    VRD(4); SBAR(); GAPA(C1 = MFMA(kf[1], qr[0], C1),     P0[6], P0[7], P0[8], P0[9],     pw0[2] = PKW(P0, 4),  pw0[3] = PKW(P0, 6),  pw0); \
    VRD(1); SBAR(); GAPA(C0 = MFMA(kf[2], qr[1], C0),    P0[10], P0[11], P0[12], P0[13], pw1[0] = PKW(P0, 8),  pw1[1] = PKW(P0, 10), pw1); \
    VRD(5); SBAR(); GAPA(C1 = MFMA(kf[3], qr[1], C1),    P0[14], P0[15], P1[0], P1[1],   pw1[2] = PKW(P0, 12), pw1[3] = PKW(P0, 14), pw1); \
    VRD(2); SBAR(); GAPA(C0 = MFMA(kf[4], qr[2], C0),    P1[2], P1[3], P1[4], P1[5],     pw2[0] = PKW(P1, 0),  pw2[1] = PKW(P1, 2),  pw2); \
    VRD(6); SBAR(); GAPA(C1 = MFMA(kf[5], qr[2], C1),    P1[6], P1[7], P1[8], P1[9],     pw2[2] = PKW(P1, 4),  pw2[3] = PKW(P1, 6),  pw2); \
    VRD(3); SBAR(); GAPA(C0 = MFMA(kf[6], qr[3], C0),    P1[10], P1[11], P1[12], P1[13], pw3[0] = PKW(P1, 8),  pw3[1] = PKW(P1, 10), pw3); \
    VRD(7); SBAR(); GAPA(C1 = MFMA(kf[7], qr[3], C1),    P1[14], P1[15], 0.f, 0.f,       pw3[2] = PKW(P1, 12), pw3[3] = PKW(P1, 14), pw3); \
    l_reg += sacc; \
    if (GK) DMA_K((t) + 3, sl_cur); if (GV) DMA_V((t) + 1, sl_next); \
    if (MASK) bandfix(C0, C1, (t) - (NT - 4), qrel, hi, bt); \
    { const float rm = __builtin_fmaf(rowmax(C0, C1), C2, -mhat); resc = false; \
      if (__builtin_expect(__any(rm > (float)ATHR), 0)) { const float dl = __builtin_fmaxf(rm, 0.f); mhat += dl; \
          const float f = __builtin_amdgcn_exp2f(-dl); l_reg *= f; if (hi == 0) wsf[r32] = f; resc = true; } } \
    const float nmh = -mhat; SBAR(); \
    GAPB(o[0] = MFMA(PAF(0), VFR(0), o[0]), C0, 0);              GAPB(o[1] = MFMA(PAF(0), VFR(4), o[1]), C0, 4); \
    KRD(GL, 0); GAPB(o[0] = MFMA(PAF(1), VFR(1), o[0]), C0, 8);  KRD(GL, 1); GAPB(o[1] = MFMA(PAF(1), VFR(5), o[1]), C0, 12); \
    KRD(GL, 2); GAPB(o[0] = MFMA(PAF(2), VFR(2), o[0]), C1, 0);  KRD(GL, 3); GAPB(o[1] = MFMA(PAF(2), VFR(6), o[1]), C1, 4); \
    GAPB(o[0] = MFMA(PAF(3), VFR(3), o[0]), C1, 8);              GAPB(o[1] = MFMA(PAF(3), VFR(7), o[1]), C1, 12); \
    } while (0)
    int t = 1;
    for (; t + 7 < NT; t += 2) {
        STEP(pB0, pB1, pA0, pA1, t, false, true, true, true);     WAIT_BAR(2); RESC(); ROT();
        STEP(pA0, pA1, pB0, pB1, t + 1, false, true, true, true); WAIT_BAR(2); RESC(); ROT();
    }
#define ENDW(tt) do { if ((tt) + 3 < NT) { WAIT_BAR(2); } else if ((tt) + 2 < NT) { WAIT_BAR(1); } else { WAIT_BAR(0); } } while (0)
    for (; t + 1 < NT; t += 2) {
        STEP(pB0, pB1, pA0, pA1, t, true, (t + 3 < NT), (t + 1 < NT), (t + 1 < NT));         ENDW(t);     RESC(); ROT();
        STEP(pA0, pA1, pB0, pB1, t + 1, true, (t + 4 < NT), (t + 2 < NT), (t + 2 < NT));     ENDW(t + 1); RESC(); ROT();
    }
    STEP(pB0, pB1, pA0, pA1, NT - 1, true, false, false, false); RESC();
    { float sacc = pB0[0] + pB0[1];
#pragma unroll
      for (int r = 2; r < 16; ++r) sacc += pB0[r];
#pragma unroll
      for (int r = 0; r < 16; ++r) sacc += pB1[r];
      l_reg += sacc;
      pw0 = (u32x4){PKW(pB0, 0), PKW(pB0, 2), PKW(pB0, 4), PKW(pB0, 6)}; pw1 = (u32x4){PKW(pB0, 8), PKW(pB0, 10), PKW(pB0, 12), PKW(pB0, 14)};
      pw2 = (u32x4){PKW(pB1, 0), PKW(pB1, 2), PKW(pB1, 4), PKW(pB1, 6)}; pw3 = (u32x4){PKW(pB1, 8), PKW(pB1, 10), PKW(pB1, 12), PKW(pB1, 14)};
      const lds_cptr vp_ = vp0 + sl_cur; _Pragma("unroll") for (int i = 0; i < 8; ++i) VRD(i);
      o[0] = MFMA(PAF(0), VFR(0), o[0]); o[1] = MFMA(PAF(0), VFR(4), o[1]); o[0] = MFMA(PAF(1), VFR(1), o[0]); o[1] = MFMA(PAF(1), VFR(5), o[1]);
      o[0] = MFMA(PAF(2), VFR(2), o[0]); o[1] = MFMA(PAF(2), VFR(6), o[1]); o[0] = MFMA(PAF(3), VFR(3), o[0]); o[1] = MFMA(PAF(3), VFR(7), o[1]); }
    { auto rr = __builtin_amdgcn_permlane32_swap(__float_as_uint(l_reg), __float_as_uint(l_reg), false, false); l_reg = __uint_as_float(rr[0]) + __uint_as_float(rr[1]); }
    if (hi == 0) wsf[32 + r32] = l_reg; asm volatile("s_waitcnt lgkmcnt(0)" ::: "memory");
    float rli[16];
#pragma unroll
    for (int r = 0; r < 16; ++r) rli[r] = __builtin_amdgcn_rcpf(wsf[32 + crow(r, hi)]);
    bf16_t* Ow = O + (rowbase + q0 + wid * QBLK) * OD + h * D; bf16_t* stg = (bf16_t*)(lds + LDS_OST) + wid * 2048;
#pragma unroll
    for (int r = 0; r < 16; ++r) { const int orow = crow(r, hi);
#pragma unroll
        for (int d0 = 0; d0 < 2; ++d0) stg[orow * 64 + d0 * 32 + r32] = f2bf(o[d0][r] * rli[r]); }
    asm volatile("s_waitcnt lgkmcnt(0)" ::: "memory");
#pragma unroll
    for (int i = 0; i < 4; ++i) { const int row = i * 8 + (lane >> 3), ch = lane & 7; *(u32x4*)(Ow + (long)row * OD + ch * 8) = *(const u32x4*)(stg + row * 64 + ch * 8); }
    asm volatile("s_waitcnt lgkmcnt(0)\n\ts_barrier" ::: "memory");
#undef DMA_K
#undef DMA_V
#undef ROT
#undef EX
#undef RESC
#undef PKW
#undef PAF
#undef VFR
#undef VRD
#undef KRD
#undef ENDW
#undef GAPA
#undef GAPB
#undef STEP
}
}

__device__ __forceinline__ float reduce32(float (&v)[32], int lane) {
#pragma unroll
    for (int off = 32, n = 16; n >= 1; off >>= 1, n >>= 1) {
        const bool up = (lane & off) != 0;
#pragma unroll
        for (int i = 0; i < n; ++i) { const float keep = up ? v[i + n] : v[i], send = up ? v[i] : v[i + n]; v[i] = keep + __shfl_xor(send, off); }
    }
    return v[0] + __shfl_xor(v[0], 1);
}
__device__ __forceinline__ void p7_ln_router(Frame& F) {
    float* z = (float*)(F.ws + WS_R1); bf16_t* x1b = (bf16_t*)(F.ws + WS_XB);
    int* tokl = (int*)(F.ws + WS_TOK); float* gatel = (float*)(F.ws + WS_GATE); int* pairl = (int*)(F.ws + WS_PAIR); unsigned* cnt = (unsigned*)(F.ws + WS_CTL) + CW_CNT;
    LAS float* WR = (LAS float*)F.lds;
    LAS int* PB = (LAS int*)(F.lds + 131072);
    LAS int* HIST = (LAS int*)(F.lds + 131072 + 16384);
    const int tid = F.tid, lane = F.lane, w = F.wave;
    for (int i = tid; i < 32 * 1024; i += 512) { const int k = i >> 5, e = i & 31; WR[e * 1024 + k] = F.w_router[i]; }
    if (tid < 64) HIST[tid] = 0;
    __syncthreads();
    const int per = (T + F.G - 1) / F.G; const int t0 = F.bid * per, t1 = (t0 + per < T) ? t0 + per : T;
    int npair = 0;
    for (int t = t0 + w; t < t1; t += 8) {
        f32x4* zr = (f32x4*)(z + (size_t)t * 1024) + lane; f32x4 v[4]; float s = 0.f;
#pragma unroll
        for (int j = 0; j < 4; ++j) { v[j] = zr[64 * j]; s += (v[j][0] + v[j][1]) + (v[j][2] + v[j][3]); }
        const float mean = wave_sum(s) * (1.f / 1024.f); float s2 = 0.f;
#pragma unroll
        for (int j = 0; j < 4; ++j) { v[j] = v[j] - mean; s2 += (v[j][0] * v[j][0] + v[j][1] * v[j][1]) + (v[j][2] * v[j][2] + v[j][3] * v[j][3]); }
        const float rstd = 1.f / sqrtf(wave_sum(s2) * (1.f / 1024.f) + LN_EPS);
        u32x2* xb = (u32x2*)(x1b + (size_t)t * 1024) + lane;
#pragma unroll
        for (int j = 0; j < 4; ++j) { const f32x4 g = *((const f32x4*)F.ln1_g + 64 * j + lane), bb = *((const f32x4*)F.ln1_b + 64 * j + lane);
            v[j] = v[j] * rstd * g + bb; zr[64 * j] = v[j]; u32x2 pk; pk.x = cvt_pk_bf16(v[j][0], v[j][1]); pk.y = cvt_pk_bf16(v[j][2], v[j][3]); xb[64 * j] = pk; }
        float lg[32];
#pragma unroll
        for (int e = 0; e < 32; ++e) { float a = 0.f;
#pragma unroll
            for (int j = 0; j < 4; ++j) { const f32x4 wv = *((const LAS f32x4*)(WR + e * 1024) + 64 * j + lane); a += (v[j][0] * wv[0] + v[j][1] * wv[1]) + (v[j][2] * wv[2] + v[j][3] * wv[3]); }
            lg[e] = a; }
        float logit = reduce32(lg, lane); const int myE = (lane >> 1) & 31; logit += F.b_router[myE];
        float tv[4]; int te[4]; float cur = logit;
#pragma unroll
        for (int k = 0; k < 4; ++k) { float bv = cur; int be = myE;
#pragma unroll
            for (int o = 2; o < 64; o <<= 1) { const float ov = __shfl_xor(bv, o); const int oe = __shfl_xor(be, o); if (ov > bv || (ov == bv && oe < be)) { bv = ov; be = oe; } }
            tv[k] = bv; te[k] = be; if (myE == be) cur = -INFINITY; }
        const float e1 = __expf(tv[1] - tv[0]), e2 = __expf(tv[2] - tv[0]), e3 = __expf(tv[3] - tv[0]); const float inv = 1.f / (1.f + e1 + e2 + e3);
        if (lane < 4) { const float gk = (lane == 0 ? 1.f : lane == 1 ? e1 : lane == 2 ? e2 : e3) * inv; const int ek = (lane == 0 ? te[0] : lane == 1 ? te[1] : lane == 2 ? te[2] : te[3]);
            const int li = atomicAdd((int*)&HIST[ek], 1); const int pi = ((t - t0) * 4 + lane);
            PB[pi * 4 + 0] = t; PB[pi * 4 + 1] = ek; PB[pi * 4 + 2] = __float_as_int(gk); PB[pi * 4 + 3] = li; }
    }
    npair = (t1 - t0) * 4;
    __syncthreads();
    if (tid < 32) HIST[32 + tid] = (int)atomicAdd(&cnt[tid], (unsigned)HIST[tid]);
    __syncthreads();
    for (int p = tid; p < npair; p += 512) { const int t = PB[p * 4], e = PB[p * 4 + 1], slot = HIST[32 + e] + PB[p * 4 + 3];
        tokl[e * ECAP + slot] = t; gatel[e * ECAP + slot] = __int_as_float(PB[p * 4 + 2]); pairl[t * 4 + (p & 3)] = (e << 16) | slot; }
    __syncthreads();
}
__device__ __forceinline__ void moe_tables(Frame& F, LAS int* tstart, LAS int* cntl) {
    const unsigned* cnt = (const unsigned*)(F.ws + WS_CTL) + CW_CNT;
    if (F.tid < 32) cntl[F.tid] = (int)__hip_atomic_load(cnt + F.tid, __ATOMIC_RELAXED, __HIP_MEMORY_SCOPE_AGENT);
    __syncthreads();
    if (F.tid == 0) { int a = 0; for (int e = 0; e < 32; ++e) { tstart[e] = a; a += (cntl[e] + 255) >> 8; } tstart[32] = a; }
    __syncthreads();
}
__device__ __forceinline__ void p11_combine(Frame& F, const LAS int* tstart) {
    const float* x1 = (const float*)(F.ws + WS_R1); const bf16_t* y2 = (const bf16_t*)(F.ws + WS_Y2); const int* pairl = (const int*)(F.ws + WS_PAIR);
    const int lane = F.lane; const int gw = F.bid * 8 + F.wave, NGW = F.G * 8;
    for (int t = gw; t < T; t += NGW) {
        const f32x4* xr = (const f32x4*)(x1 + (size_t)t * 1024) + lane; f32x4 v[4];
#pragma unroll
        for (int j = 0; j < 4; ++j) v[j] = xr[64 * j] * DN_ALPHA;
#pragma unroll
        for (int k = 0; k < 4; ++k) { const int pr = pairl[t * 4 + k]; const int e = pr >> 16, slot = pr & 0xffff; const size_t row = (size_t)tstart[e] * 256 + slot;
            const u32x2* yr = (const u32x2*)(y2 + row * 1024) + lane;
#pragma unroll
            for (int j = 0; j < 4; ++j) { const u32x2 q = yr[64 * j]; v[j][0] += bflo(q.x); v[j][1] += bfhi(q.x); v[j][2] += bflo(q.y); v[j][3] += bfhi(q.y); } }
        float s = 0.f;
#pragma unroll
        for (int j = 0; j < 4; ++j) s += (v[j][0] + v[j][1]) + (v[j][2] + v[j][3]);
        const float mean = wave_sum(s) * (1.f / 1024.f); float s2 = 0.f;
#pragma unroll
        for (int j = 0; j < 4; ++j) { v[j] = v[j] - mean; s2 += (v[j][0] * v[j][0] + v[j][1] * v[j][1]) + (v[j][2] * v[j][2] + v[j][3] * v[j][3]); }
        const float rstd = 1.f / sqrtf(wave_sum(s2) * (1.f / 1024.f) + LN_EPS);
        f32x4* orow = (f32x4*)(F.out + (size_t)t * 1024) + lane;
#pragma unroll
        for (int j = 0; j < 4; ++j) { const f32x4 g = *((const f32x4*)F.ln2_g + 64 * j + lane), bb = *((const f32x4*)F.ln2_b + 64 * j + lane); orow[64 * j] = v[j] * rstd * g + bb; }
    }
}

struct Args { const float* in[21]; float* out; unsigned char* ws; int ph_lo, ph_hi; };
__device__ __forceinline__ const float* arg_in(int k) {
    typedef const float* cfp;
    const __attribute__((address_space(4))) cfp* ka = (const __attribute__((address_space(4))) cfp*)__builtin_amdgcn_kernarg_segment_ptr();
    int kk = k; asm volatile("" : "+s"(kk));
    return ka[kk];
}
__device__ __forceinline__ void frame_init(Frame& F, unsigned char* lds_dyn) {
    F.lds = (LAS unsigned char*)lds_dyn; F.ws = (unsigned char*)arg_in(22);
    { int t_ = threadIdx.x; asm volatile("" : "+v"(t_)); F.tid = t_; } F.lane = F.tid & 63; F.wave = __builtin_amdgcn_readfirstlane(F.tid >> 6); F.G = gridDim.x; F.bid = blockIdx.x;
    F.x = arg_in(0); F.w_in = arg_in(1); F.conv_w = arg_in(2); F.conv_b = arg_in(3); F.i_bias = arg_in(4); F.f_bias = arg_in(5); F.norm_g = arg_in(6);
    F.w_ba = arg_in(7); F.w_bm = arg_in(8); F.w_out = arg_in(9); F.ln1_g = arg_in(10); F.ln1_b = arg_in(11); F.w_router = arg_in(12); F.b_router = arg_in(13);
    F.w_gu = arg_in(14); F.b_gu = arg_in(15); F.w_down = arg_in(16); F.b_down = arg_in(17); F.ln2_g = arg_in(18); F.ln2_b = arg_in(19); F.rel_bias = arg_in(20);
    F.out = (float*)arg_in(21);
}
template <int PH>
__device__ __forceinline__ void phase_body(unsigned char* lds_dyn) {
    Frame F; frame_init(F, lds_dyn);
    LAS int* TST = (LAS int*)(F.lds + LDS_MISC + 256); LAS int* CNTL = TST + 40;
    if constexpr (PH == 0) { p0_prologue(F); }
    if constexpr (PH == 1) {
        pg8::DenseOrder S{(const char*)(F.ws + WS_XB), (const char*)(F.ws + WS_WIN), 1024, 1024, T / 256, NWIN / 256, F.G, F.bid};
        EpiProj E{(bf16_t*)(F.ws + WS_PROJ), (bf16_t*)(F.ws + WS_KI), (float*)(F.ws + WS_SMALL)};
        pg8::gemm_phase<EpiProj, pg8::DenseOrder>(F.lds, 1024, S, E);
    }
    if constexpr (PH == 2) {
        for (int u = F.bid; u < 256; u += F.G) { const int b = u & 7, j = u >> 3;
#pragma unroll 1
            for (int q = 0; q < 4; ++q) { const int qb = (q == 0) ? j : (q == 1) ? 63 - j : (q == 2) ? 64 + j : 127 - j; idx_unit(F, b, qb); } }
#pragma unroll 1
        for (int u = F.bid; u < 512; u += F.G) mlstm_local_unit(F, u >> 6, u & 63);
    }
    if constexpr (PH == 3) {
        mlstm_scan(F);
        LAS float* BT = (LAS float*)(F.lds + at64::LDS_BT);
        for (int i = F.tid; i < 8 * 128; i += 512) { const int h = i >> 7, n = i & 127; int bk;
            if (n < 16) bk = n; else { bk = 16 + (int)(logf((float)n / 16.0f) / 2.0794415416798357f * 16.0f); bk = bk > 31 ? 31 : bk; }
            BT[i] = (F.rel_bias[h * 32 + bk] - F.rel_bias[h * 32 + 31]) * 8.0f; }
        __syncthreads();
        const bf16_t* proj = (const bf16_t*)(F.ws + WS_PROJ);
#pragma unroll 1
        for (int p2 = F.bid * 2; p2 < 1024; p2 += F.G * 2) {
#pragma unroll 1
            for (int q = 0; q < 2; ++q) { const int p = p2 >> 1; const int x = p & 7, kk = p >> 3, bh = x + 8 * (kk >> 3), j = kk & 7; const int qb = q ? 15 - j : j;
                at64::attn64_unit(bh >> 3, bh & 7, qb, proj + C_QA, proj + C_KA, proj + C_VA, (bf16_t*)(F.ws + WS_YCAT), (const unsigned long long*)(F.ws + WS_MW), (char*)lds_dyn, BT); } }
    }
    if constexpr (PH == 4) {
#pragma unroll 1
        for (int u = F.bid; u < 512; u += F.G) mlstm_out_unit(F, u >> 6, u & 63); }
    if constexpr (PH == 5) {
        pg8::MergeOrder S{(const char*)(F.ws + WS_YCAT), (const char*)(F.ws + WS_WCAT), F.G, F.bid};
        EpiMerge E{(const bf16_t*)(F.ws + WS_PROJ), (bf16_t*)(F.ws + WS_MIX)};
        pg8::gemm_phase<EpiMerge, pg8::MergeOrder>(F.lds, 512, S, E);
    }
    if constexpr (PH == 6) {
        pg8::DenseOrder S{(const char*)(F.ws + WS_MIX), (const char*)(F.ws + WS_WO), 1024, 1024, T / 256, 4, F.G, F.bid};
        EpiOut E{F.x, (float*)(F.ws + WS_R1)};
        pg8::gemm_phase<EpiOut, pg8::DenseOrder>(F.lds, 1024, S, E);
    }
    if constexpr (PH == 7) { p7_ln_router(F); }
    if constexpr (PH == 9) {
        moe_tables(F, TST, CNTL);
        pg8::MoeOrder S{TST, CNTL, (const char*)(F.ws + WS_XB), (const char*)(F.ws + WS_WGU), (const int*)(F.ws + WS_TOK), 8, F.G, F.bid, (size_t)2048 * 1024 * 2, true};
        EpiGateUp E{F.b_gu, (bf16_t*)(F.ws + WS_PROJ)};
        pg8::gemm_phase<EpiGateUp, pg8::MoeOrder>(F.lds, 1024, S, E);
    }
    if constexpr (PH == 10) {
        moe_tables(F, TST, CNTL);
        pg8::MoeOrder S{TST, CNTL, (const char*)(F.ws + WS_PROJ), (const char*)(F.ws + WS_WD), (const int*)(F.ws + WS_TOK), 4, F.G, F.bid, (size_t)1024 * 1024 * 2, false};
        EpiDown E{F.b_down, (const float*)(F.ws + WS_GATE), (bf16_t*)(F.ws + WS_Y2)};
        pg8::gemm_phase<EpiDown, pg8::MoeOrder>(F.lds, 1024, S, E);
    }
    if constexpr (PH == 11) { moe_tables(F, TST, CNTL); p11_combine(F, TST); }
}
#if MK_PER_PHASE
template <int PH>
__global__ void __launch_bounds__(512, 2) mk_phase(Args args) {
    extern __shared__ __attribute__((aligned(16))) unsigned char lds_dyn[];
    phase_body<PH>(lds_dyn);
}
#else
__global__ void __launch_bounds__(512, 2) mk_fwd(Args args) {
    extern __shared__ __attribute__((aligned(16))) unsigned char lds_dyn[];
    volatile LAS unsigned* MISC = (volatile LAS unsigned*)((LAS unsigned char*)lds_dyn + LDS_MISC);
    if (threadIdx.x < 64) MISC[threadIdx.x] = 0u;
    __syncthreads();
    XcdBarrier bar = xcd_barrier_post((unsigned*)((unsigned char*)arg_in(22) + WS_CTL) + CW_BAR, MISC + 8);
    phase_body<0>(lds_dyn); xcd_barrier(bar);
    phase_body<1>(lds_dyn); xcd_barrier(bar);
    phase_body<2>(lds_dyn); xcd_barrier(bar);
    phase_body<3>(lds_dyn); xcd_barrier(bar);
    phase_body<4>(lds_dyn); xcd_barrier(bar);
    phase_body<5>(lds_dyn); xcd_barrier(bar);
    phase_body<6>(lds_dyn); xcd_barrier(bar);
    phase_body<7>(lds_dyn); xcd_barrier(bar);
    phase_body<9>(lds_dyn); xcd_barrier(bar);
    phase_body<10>(lds_dyn); xcd_barrier(bar);
    phase_body<11>(lds_dyn);
}
#endif

template <class KF> static bool setup_kernel(KF kf) {
    if (hipFuncSetAttribute((const void*)kf, hipFuncAttributeMaxDynamicSharedMemorySize, LDS_BYTES) != hipSuccess) { fprintf(stderr, "kernel_launch: hipFuncSetAttribute failed\n"); return false; }
    return true;
}
extern "C" void kernel_launch(void* const* d_in, const int* in_sizes, int n_in, void* d_out, int out_size, void* d_ws, size_t ws_size, hipStream_t stream) {
    static int grid = 0;
    if (grid == 0) {
        if (n_in != 21 || ws_size < WS_END) { fprintf(stderr, "kernel_launch: unexpected n_in %d / ws %zu\n", n_in, ws_size); grid = -1; return; }
        int dev = 0, cus = 0;
        (void)hipGetDevice(&dev); (void)hipDeviceGetAttribute(&cus, hipDeviceAttributeMultiprocessorCount, dev);
        bool ok = true;
#if MK_PER_PHASE
        ok = ok && setup_kernel(mk_phase<0>) && setup_kernel(mk_phase<1>) && setup_kernel(mk_phase<2>) && setup_kernel(mk_phase<3>) && setup_kernel(mk_phase<4>) && setup_kernel(mk_phase<5>)
                && setup_kernel(mk_phase<6>) && setup_kernel(mk_phase<7>) && setup_kernel(mk_phase<9>) && setup_kernel(mk_phase<10>) && setup_kernel(mk_phase<11>);
#else
        ok = ok && setup_kernel(mk_fwd);
        int per_cu = 0;
        if (hipOccupancyMaxActiveBlocksPerMultiprocessor(&per_cu, (const void*)mk_fwd, 512, LDS_BYTES) != hipSuccess || per_cu < 1) { fprintf(stderr, "kernel_launch: occupancy query says %d\n", per_cu); }
#endif
        (void)hipGetLastError();
        if (!ok) { grid = -1; return; }
        grid = cus > 0 ? cus : 256;
        if (grid > 256) grid = 256;
    }
    if (grid < 0) return;
    (void)hipMemsetAsync((char*)d_ws + WS_CTL, 0, CTL_BYTES, stream);
    Args a{};
    for (int i = 0; i < 21; ++i) a.in[i] = (const float*)d_in[i];
    a.out = (float*)d_out; a.ws = (unsigned char*)d_ws; a.ph_lo = 0; a.ph_hi = NPHASE;
#if MK_PER_PHASE
    hipLaunchKernelGGL(mk_phase<0>, dim3(grid), dim3(512), LDS_BYTES, stream, a);
    hipLaunchKernelGGL(mk_phase<1>, dim3(grid), dim3(512), LDS_BYTES, stream, a);
    hipLaunchKernelGGL(mk_phase<2>, dim3(grid), dim3(512), LDS_BYTES, stream, a);
    hipLaunchKernelGGL(mk_phase<3>, dim3(grid), dim3(512), LDS_BYTES, stream, a);
    hipLaunchKernelGGL(mk_phase<4>, dim3(grid), dim3(512), LDS_BYTES, stream, a);
    hipLaunchKernelGGL(mk_phase<5>, dim3(grid), dim3(512), LDS_BYTES, stream, a);
    hipLaunchKernelGGL(mk_phase<6>, dim3(grid), dim3(512), LDS_BYTES, stream, a);
    hipLaunchKernelGGL(mk_phase<7>, dim3(grid), dim3(512), LDS_BYTES, stream, a);
    hipLaunchKernelGGL(mk_phase<9>, dim3(grid), dim3(512), LDS_BYTES, stream, a);
    hipLaunchKernelGGL(mk_phase<10>, dim3(grid), dim3(512), LDS_BYTES, stream, a);
    hipLaunchKernelGGL(mk_phase<11>, dim3(grid), dim3(512), LDS_BYTES, stream, a);
#else
    hipLaunchKernelGGL(mk_fwd, dim3(grid), dim3(512), LDS_BYTES, stream, a);
#endif
}
```
